# Optimizing an MI355X kernel written in HIP

```python
import jax, jax.numpy as jnp
from jax import lax
import numpy as np

D_MODEL = 1024
BATCH = 8
SEQ = 2048
DEPTH = 2
DEC_BATCH = 128
DEC_SEQ = 8
PAST_LEN = 16384
PAGE_SIZE = 128

H_A = 6
DK_A = 64
DV_A = 64
QK_A = H_A * DK_A
W_A = H_A * DV_A
CONV_A = 4
W_B = 256
LRU_BLOCKS = 4
LRU_BLOCK = W_B // LRU_BLOCKS
CONV_B = 4
LRU_C = 8.0
H_C = 6
DK_C = 32
DV_C = 64
QK_C = H_C * DK_C
W_C = H_C * DV_C
GLA_RANK = 16
GLA_TAU = 16.0
D_MIX = W_A + W_B + W_C
CHUNK = 64
D_FF = 2816
CONV_F = 3
ALPHA = (2.0 * DEPTH) ** 0.25
BETA_INIT = (8.0 * DEPTH) ** -0.25
EPS = 1e-6

SPLIT_SIZES = (QK_A, QK_A, W_A, W_A, H_A, H_A,
               W_B, W_B,
               QK_C, QK_C, W_C, W_C, GLA_RANK)
D_IN = sum(SPLIT_SIZES)
SPLIT_POINTS = tuple(int(s) for s in np.cumsum(SPLIT_SIZES)[:-1])
CONV_A_WIDTH = 2 * QK_A + W_A

kernel_name = 'hybrid_deltanet_rglru_gla_step'


def layer_norm(x, g, b):
    xf = x.astype(jnp.float32)
    mu = xf.mean(-1, keepdims=True)
    var = jnp.square(xf - mu).mean(-1, keepdims=True)
    return ((xf - mu) * lax.rsqrt(var + EPS) * g.astype(jnp.float32) + b.astype(jnp.float32)).astype(x.dtype)


def head_rms_norm(o, g):
    return o * lax.rsqrt(jnp.mean(jnp.square(o), -1, keepdims=True) + EPS) * g.astype(jnp.float32)


def l2norm(x):
    xf = x.astype(jnp.float32)
    return xf * lax.rsqrt(jnp.sum(jnp.square(xf), -1, keepdims=True) + EPS)


def causal_dwconv(x, buf, w):
    width = w.shape[0]
    T = x.shape[1]
    xp = jnp.concatenate([buf.astype(x.dtype), x], axis=1)
    y = xp[:, 0:T] * w[0]
    for i in range(1, width):
        y = y + xp[:, i:i + T] * w[i]
    return y, xp[:, -(width - 1):]


def chunk_size(T):
    return CHUNK if T % CHUNK == 0 else T


def to_chunks(x, c):
    B, T, H, D = x.shape
    return x.reshape(B, T // c, c, H, D).transpose(1, 0, 3, 2, 4)


def from_chunks(x):
    n, B, H, c, D = x.shape
    return x.transpose(1, 0, 3, 2, 4).reshape(B, n * c, H, D)


def gated_delta_chunked(q, k, v, beta, g, s0):
    f32 = jnp.float32
    T = q.shape[1]
    dv = v.shape[-1]
    c = chunk_size(T)
    qc, kc, vc = (to_chunks(t.astype(f32), c) for t in (q, k, v))
    bc = to_chunks(beta.astype(f32)[..., None], c)[..., 0]
    gc = to_chunks(g.astype(f32)[..., None], c)[..., 0]
    incl = jnp.tril(jnp.ones((c, c), bool))
    strict = jnp.tril(jnp.ones((c, c), bool), -1)
    eye = jnp.eye(c, dtype=f32)

    def step(S, inp):
        qi, ki, vi, bi, gi = inp
        gcum = jnp.cumsum(gi, axis=-1)
        diff = gcum[..., :, None] - gcum[..., None, :]
        dec_incl = jnp.exp(jnp.where(incl, diff, -jnp.inf))
        dec_strict = jnp.where(strict, dec_incl, 0.0)
        kk = jnp.einsum('bhid,bhjd->bhij', ki, ki)
        lhs = eye + bi[..., :, None] * kk * dec_strict
        rhs = jnp.concatenate([bi[..., None] * vi, (bi * jnp.exp(gcum))[..., None] * ki], axis=-1)
        sol = lax.linalg.triangular_solve(lhs, rhs, left_side=True, lower=True, unit_diagonal=True)
        u, wk = sol[..., :dv], sol[..., dv:]
        w = u - jnp.einsum('bhik,bhkv->bhiv', wk, S)
        qk = jnp.einsum('bhid,bhjd->bhij', qi, ki) * dec_incl
        o = jnp.exp(gcum)[..., None] * jnp.einsum('bhik,bhkv->bhiv', qi, S) + jnp.einsum('bhij,bhjv->bhiv', qk, w)
        g_last = gcum[..., -1:]
        k_dec = ki * jnp.exp(g_last - gcum)[..., None]
        S_new = jnp.exp(g_last)[..., None] * S + jnp.einsum('bhjk,bhjv->bhkv', k_dec, w)
        return S_new, o

    S, o = lax.scan(step, s0.astype(f32), (qc, kc, vc, bc, gc))
    return from_chunks(o), S


def gla_chunked(q, k, v, logf, s0):
    f32 = jnp.float32
    T = q.shape[1]
    c = chunk_size(T)
    qc, kc, vc, fc = (to_chunks(t.astype(f32), c) for t in (q, k, v, logf))
    incl = jnp.tril(jnp.ones((c, c), bool))[..., None]

    def step(S, inp):
        qi, ki, vi, fi = inp
        b = jnp.cumsum(fi, axis=-2)
        diff = b[..., :, None, :] - b[..., None, :, :]
        dec = jnp.exp(jnp.where(incl, diff, -jnp.inf))
        att = jnp.einsum('bhik,bhjk,bhijk->bhij', qi, ki, dec)
        o = jnp.einsum('bhik,bhkv->bhiv', qi * jnp.exp(b), S) + jnp.einsum('bhij,bhjv->bhiv', att, vi)
        b_last = b[..., -1:, :]
        S_new = jnp.exp(b_last[..., 0, :])[..., None] * S + jnp.einsum('bhjk,bhjv->bhkv', ki * jnp.exp(b_last - b), vi)
        return S_new, o

    S, o = lax.scan(step, s0.astype(f32), (qc, kc, vc, fc))
    return from_chunks(o), S


def rg_lru(xc, h0, w_r, b_r, w_i, b_i, lam):
    f32 = jnp.float32
    B, T, _ = xc.shape
    xf = xc.astype(f32)
    xb = xf.reshape(B, T, LRU_BLOCKS, LRU_BLOCK)
    r = jax.nn.sigmoid(jnp.einsum('btnd,nde->btne', xb, w_r.astype(f32)).reshape(B, T, W_B) + b_r.astype(f32))
    i = jax.nn.sigmoid(jnp.einsum('btnd,nde->btne', xb, w_i.astype(f32)).reshape(B, T, W_B) + b_i.astype(f32))
    log_a = -LRU_C * r * jax.nn.softplus(-lam.astype(f32))
    a = jnp.exp(log_a)
    bx = jnp.sqrt(-jnp.expm1(2.0 * log_a)) * (i * xf)
    bx = bx.at[:, 0].add(a[:, 0] * h0.astype(f32))

    def combine(left, right):
        a1, b1 = left
        a2, b2 = right
        return a1 * a2, a2 * b1 + b2

    _, h = lax.associative_scan(combine, (a, bx), axis=1)
    return h, h[:, -1]


def conv_ffn(x, buf, w_up, conv_w, conv_b, w_down):
    up = x @ w_up
    gate, val = jnp.split(up, [D_FF], axis=-1)
    gate, buf_new = causal_dwconv(gate, buf, conv_w)
    h = jax.nn.gelu(gate + conv_b) * val
    return h @ w_down, buf_new


def _layer(x, st_dconv, st_delta, st_lconv, st_lru, st_gla, st_fconv,
           w_in, conv_a_w, a_log, dt_bias, norm_a_w, conv_b_w, conv_b_b,
           lru_w_r, lru_b_r, lru_w_i, lru_b_i, lru_lambda, gla_w2, gla_b2, norm_c_w,
           w_out, ln1_g, ln1_b, ffn_w_up, ffn_conv_w, ffn_conv_b, ffn_w_down, ln2_g, ln2_b):
    f32 = jnp.float32
    B, T, _ = x.shape
    proj = x @ w_in
    (qa, ka, va, za, ba, aa, xb, gb, qc, kc, vc, zc, lc) = jnp.split(proj, SPLIT_POINTS, axis=-1)

    qkv, dconv_new = causal_dwconv(jnp.concatenate([qa, ka, va], axis=-1), st_dconv, conv_a_w)
    qkv = jax.nn.silu(qkv)
    qa, ka, va = jnp.split(qkv, [QK_A, 2 * QK_A], axis=-1)
    qa = l2norm(qa.reshape(B, T, H_A, DK_A)) * DK_A ** -0.5
    ka = l2norm(ka.reshape(B, T, H_A, DK_A))
    va = va.reshape(B, T, H_A, DV_A)
    beta = jax.nn.sigmoid(ba.astype(f32))
    g = -jnp.exp(a_log.astype(f32)) * jax.nn.softplus(aa.astype(f32) + dt_bias.astype(f32))
    oa, delta_new = gated_delta_chunked(qa, ka, va, beta, g, st_delta)
    oa = head_rms_norm(oa, norm_a_w) * jax.nn.silu(za.reshape(B, T, H_A, DV_A).astype(f32))

    xb, lconv_new = causal_dwconv(xb, st_lconv, conv_b_w)
    ob, lru_new = rg_lru(xb + conv_b_b, st_lru, lru_w_r, lru_b_r, lru_w_i, lru_b_i, lru_lambda)
    ob = ob * jax.nn.gelu(gb.astype(f32))

    qc = qc.reshape(B, T, H_C, DK_C).astype(f32) * DK_C ** -0.5
    kc = kc.reshape(B, T, H_C, DK_C)
    vc = vc.reshape(B, T, H_C, DV_C)
    logf = jax.nn.log_sigmoid((lc @ gla_w2 + gla_b2).astype(f32)) / GLA_TAU
    oc, gla_new = gla_chunked(qc, kc, vc, logf.reshape(B, T, H_C, DK_C), st_gla)
    oc = head_rms_norm(oc, norm_c_w) * jax.nn.silu(zc.reshape(B, T, H_C, DV_C).astype(f32))

    heads = jnp.concatenate([oa.reshape(B, T, W_A), ob, oc.reshape(B, T, W_C)], axis=-1).astype(x.dtype)
    x = layer_norm(ALPHA * x + heads @ w_out, ln1_g, ln1_b)
    f, fconv_new = conv_ffn(x, st_fconv, ffn_w_up, ffn_conv_w, ffn_conv_b, ffn_w_down)
    x = layer_norm(ALPHA * x + f, ln2_g, ln2_b)
    return x, (dconv_new, delta_new, lconv_new, lru_new, gla_new, fconv_new)


def _trunk(x, states, weights):
    per_layer = []
    for l in range(DEPTH):
        x, st = _layer(x, *(s[l] for s in states), *(w[l] for w in weights))
        per_layer.append(st)
    stacked = tuple(jnp.stack([st[i] for st in per_layer]).astype(x.dtype) for i in range(len(states)))
    return x, stacked


def setup_inputs(seed: int = 0) -> dict:
    key = jax.random.key(seed)
    ks = iter(jax.random.split(key, 40))
    nrm = lambda shape, s: jax.random.normal(next(ks), shape, jnp.float32) * s
    L = DEPTH
    u_decay = jax.random.uniform(next(ks), (L, H_A), jnp.float32, 1.0, 16.0)
    dt = jnp.exp(jax.random.uniform(next(ks), (L, H_A), jnp.float32, np.log(1e-3), np.log(1e-1)))
    a8 = jax.random.uniform(next(ks), (L, W_B), jnp.float32, 0.9, 0.999)
    a1 = a8 ** (1.0 / LRU_C)
    return {
        'x_prompt': nrm((BATCH, SEQ, D_MODEL), 1.0),
        'x_sample': nrm((DEC_BATCH, DEC_SEQ, D_MODEL), 1.0),
        'state_delta_conv': nrm((L, DEC_BATCH, CONV_A - 1, CONV_A_WIDTH), 1.0),
        'state_delta': nrm((L, DEC_BATCH, H_A, DK_A, DV_A), 0.1),
        'state_lru_conv': nrm((L, DEC_BATCH, CONV_B - 1, W_B), 1.0),
        'state_lru': nrm((L, DEC_BATCH, W_B), 0.5),
        'state_gla': nrm((L, DEC_BATCH, H_C, DK_C, DV_C), 0.5),
        'state_ffn_conv': nrm((L, DEC_BATCH, CONV_F - 1, D_FF), 1.0),
        'w_in': nrm((L, D_MODEL, D_IN), D_MODEL ** -0.5),
        'conv_a_w': nrm((L, CONV_A, CONV_A_WIDTH), 0.5),
        'a_log': jnp.log(u_decay),
        'dt_bias': dt + jnp.log(-jnp.expm1(-dt)),
        'norm_a_w': 1.0 + nrm((L, DV_A), 0.1),
        'conv_b_w': nrm((L, CONV_B, W_B), 0.5),
        'conv_b_b': nrm((L, W_B), 0.02),
        'lru_w_r': nrm((L, LRU_BLOCKS, LRU_BLOCK, LRU_BLOCK), LRU_BLOCK ** -0.5),
        'lru_b_r': nrm((L, W_B), 0.02),
        'lru_w_i': nrm((L, LRU_BLOCKS, LRU_BLOCK, LRU_BLOCK), LRU_BLOCK ** -0.5),
        'lru_b_i': nrm((L, W_B), 0.02),
        'lru_lambda': jnp.log(a1) - jnp.log1p(-a1),
        'gla_w2': nrm((L, GLA_RANK, QK_C), GLA_RANK ** -0.5),
        'gla_b2': nrm((L, QK_C), 0.1),
        'norm_c_w': 1.0 + nrm((L, DV_C), 0.1),
        'w_out': nrm((L, D_MIX, D_MODEL), D_MIX ** -0.5 * BETA_INIT),
        'ln1_g': 1.0 + nrm((L, D_MODEL), 0.05),
        'ln1_b': nrm((L, D_MODEL), 0.02),
        'ffn_w_up': nrm((L, D_MODEL, 2 * D_FF), D_MODEL ** -0.5),
        'ffn_conv_w': nrm((L, CONV_F, D_FF), 0.5),
        'ffn_conv_b': nrm((L, D_FF), 0.02),
        'ffn_w_down': nrm((L, D_FF, D_MODEL), D_FF ** -0.5 * BETA_INIT),
        'ln2_g': 1.0 + nrm((L, D_MODEL), 0.05),
        'ln2_b': nrm((L, D_MODEL), 0.02),
    }


def reference(x_prompt, x_sample, state_delta_conv, state_delta, state_lru_conv, state_lru, state_gla, state_ffn_conv,
              w_in, conv_a_w, a_log, dt_bias, norm_a_w, conv_b_w, conv_b_b,
              lru_w_r, lru_b_r, lru_w_i, lru_b_i, lru_lambda, gla_w2, gla_b2, norm_c_w,
              w_out, ln1_g, ln1_b, ffn_w_up, ffn_conv_w, ffn_conv_b, ffn_w_down, ln2_g, ln2_b):
    weights = (w_in, conv_a_w, a_log, dt_bias, norm_a_w, conv_b_w, conv_b_b,
               lru_w_r, lru_b_r, lru_w_i, lru_b_i, lru_lambda, gla_w2, gla_b2, norm_c_w,
               w_out, ln1_g, ln1_b, ffn_w_up, ffn_conv_w, ffn_conv_b, ffn_w_down, ln2_g, ln2_b)
    sample_states = (state_delta_conv, state_delta, state_lru_conv, state_lru, state_gla, state_ffn_conv)
    prompt_states = tuple(jnp.zeros((DEPTH, BATCH) + s.shape[2:], x_prompt.dtype) for s in sample_states)
    y_prompt, (p_dconv, p_delta, p_lconv, p_lru, p_gla, p_fconv) = _trunk(x_prompt, prompt_states, weights)
    y_sample, (s_dconv, s_delta, s_lconv, s_lru, s_gla, s_fconv) = _trunk(x_sample, sample_states, weights)
    return (y_prompt, y_sample,
            p_dconv, p_delta, p_lconv, p_lru, p_gla, p_fconv,
            s_dconv, s_delta, s_lconv, s_lru, s_gla, s_fconv)
```

```cpp
#include <hip/hip_runtime.h>
#include <hip/hip_cooperative_groups.h>
#include <cstdio>
#include <cstdint>
namespace cg = cooperative_groups;
__device__ __forceinline__ int fresh_lane() { int x; asm volatile("v_mbcnt_lo_u32_b32 %0, -1, 0\n\tv_mbcnt_hi_u32_b32 %0, -1, %0" : "=v"(x)); return x; }
namespace pg8 {
#define PG8_LAS __attribute__((address_space(3)))
typedef unsigned short bf16_t;
typedef short bf16x8 __attribute__((ext_vector_type(8)));
typedef float f32x4 __attribute__((ext_vector_type(4)));
typedef unsigned u32x4 __attribute__((ext_vector_type(4)));
constexpr int BM = 256, BK = 64, HALF = 128, HTB = HALF * BK * 2  , STAGE_BYTES = 8 * HTB, NXCD = 8, WGM = 8;

__host__ __device__ __forceinline__ int lds_byte(int r, int c) { const int st = (r >> 4) * 2 + (c >> 5), rr = r & 15, cc = c & 31, ob = rr * 64 + cc * 2; return st * 1024 + (ob ^ (((ob >> 9) & 1) << 5)); }
__host__ __device__ __forceinline__ void stage_rc(int b, int& R, int& C) { const int st = b / 1024, sb = b % 1024, swz = sb ^ (((sb >> 9) & 1) << 5); R = (st >> 1) * 16 + swz / 64; C = (st & 1) * 32 + (swz % 64) / 2; }
__host__ __device__ __forceinline__ int perm32(int rho) { const int n = rho >> 4, i = rho & 15; return 8 * (i >> 2) + 4 * n + (i & 3); }

struct Unit { int pm, pn, k0, nt; };
struct Gemm { const bf16_t* A; const bf16_t* Bt; int M, N, K; };

struct StaticOrder {
    int nM, nN, nwg, G, c, knt;
    __host__ __device__ void init(int M, int N, int G_, int c_, int K_ = 1024) { nM = M / BM; nN = N / BM; nwg = nM * nN; G = G_; c = c_; knt = K_ / BK; }
    __host__ __device__ bool next(int i, Unit& u) const {
        const long L = (long)i * G + c; if (L >= nwg) return false;
        int wgid = (int)L; { const int q = nwg / NXCD, r = nwg % NXCD, xcd = wgid % NXCD, off = wgid / NXCD; wgid = (xcd < r ? xcd * (q + 1) : r * (q + 1) + (xcd - r) * q) + off; }
        const int nig = WGM * nN, gid = wgid / nig, fm = gid * WGM, gsz = (nM - fm) < WGM ? (nM - fm) : WGM;
        const int rem = wgid % nig; u.pm = fm + (rem & (gsz - 1)); u.pn = rem >> (31 - __builtin_clz(gsz)); u.k0 = 0; u.nt = knt; return true;
    }
    __device__ __forceinline__ void a_ready(const Unit&) const {}
    __device__ __forceinline__ void done(const Unit&) const {}
};

__device__ __forceinline__ unsigned cvt_pk_bf16(float lo, float hi) { unsigned r; asm volatile("v_cvt_pk_bf16_f32 %0, %1, %2" : "=v"(r) : "v"(lo), "v"(hi)); return r; }
struct TailOrder {
    StaticOrder so; int nsplit, G, c;
    __host__ __device__ void init(int G_, int c_, int K_) { so.init(16384, 1024, G_, c_, K_); nsplit = K_ / 256; G = G_; c = c_; }
    __host__ __device__ bool next(int i, Unit& u) const {
        const long L = (long)i * G + c;
        if (L < 256) return so.next(i, u);
        const int j = (int)L - 256; if (j >= 16 * nsplit) return false;
        const int ks = j % nsplit, uu = j / nsplit; u.pm = 64 + (uu >> 2); u.pn = uu & 3; u.k0 = ks * 256; u.nt = 4; return true;
    }
    __device__ __forceinline__ void a_ready(const Unit&) const {}
    __device__ __forceinline__ void done(const Unit&) const {}
};

typedef unsigned u32x2 __attribute__((ext_vector_type(2)));
__device__ __forceinline__ float gelu_tanh_f(float x) { const float t = 1.5957691216057308f * (x + 0.044715f * x * x * x); return x * __builtin_amdgcn_rcpf(1.0f + __expf(-t)); }

struct EpiProj {
    static constexpr bool PERM = true, AFTER_DRAIN = false;
    bf16_t* O; int ldc;
    __device__ __forceinline__ void operator()(const f32x4 (&acc)[2][2][4][2], const Unit& u, int wr, int wc, int fr, int fq) const {
        const int row0 = u.pm * BM + wr * 64 + fr, col0 = u.pn * BM + wc * 32 + 8 * fq;
#pragma unroll
        for (int ai = 0; ai < 2; ++ai)
#pragma unroll
            for (int m = 0; m < 4; ++m) { bf16_t* rowp = O + (size_t)(row0 + ai * HALF + m * 16) * ldc + col0;
#pragma unroll
                for (int bj = 0; bj < 2; ++bj) { const f32x4 v0 = acc[ai][bj][m][0], v1 = acc[ai][bj][m][1];
                    u32x4 w; w.x = cvt_pk_bf16(v0[0], v0[1]); w.y = cvt_pk_bf16(v0[2], v0[3]); w.z = cvt_pk_bf16(v1[0], v1[1]); w.w = cvt_pk_bf16(v1[2], v1[3]);
                    *(u32x4*)(rowp + bj * HALF) = w; } }
    }
};
template <bool RESB, bool OUTB> struct EpiResidT {
    static constexpr bool PERM = false, AFTER_DRAIN = false;
    const float* resP; float* out; float alpha; float* part; int nsplit; const bf16_t* resB; bf16_t* outB;
    __device__ __forceinline__ void operator()(const f32x4 (&acc)[2][2][4][2], const Unit& u, int wr, int wc, int fr, int fq) const {
        const int col0 = u.pn * BM + wc * 32 + 4 * fq;
        if (u.pm >= 64) {
            float* pt = part + (size_t)((((u.pm - 64) * 4 + u.pn) * nsplit) + (u.k0 >> 8)) * 65536;
#pragma unroll
            for (int ai = 0; ai < 2; ++ai)
#pragma unroll
                for (int m = 0; m < 4; ++m) { const unsigned ro = (unsigned)(ai * HALF + wr * 64 + m * 16 + fr) * 256u + (unsigned)(wc * 32 + 4 * fq);
#pragma unroll
                    for (int bj = 0; bj < 2; ++bj)
#pragma unroll
                        for (int n = 0; n < 2; ++n) *(f32x4*)(pt + (ro + (unsigned)(bj * HALF + n * 16))) = acc[ai][bj][m][n]; }
            return;
        }
#pragma unroll
        for (int ai = 0; ai < 2; ++ai)
#pragma unroll
            for (int m = 0; m < 4; ++m) { const unsigned ro = (unsigned)(u.pm * BM + ai * HALF + wr * 64 + m * 16 + fr) * 1024u + (unsigned)col0;
#pragma unroll
                for (int bj = 0; bj < 2; ++bj)
#pragma unroll
                    for (int n = 0; n < 2; ++n) { const unsigned o = ro + (unsigned)(bj * HALF + n * 16); f32x4 x; if constexpr (RESB) { const u32x2 rw = *(const u32x2*)(resB + o); x = (f32x4){__uint_as_float(rw.x << 16), __uint_as_float(rw.x & 0xffff0000u), __uint_as_float(rw.y << 16), __uint_as_float(rw.y & 0xffff0000u)}; } else x = *(const f32x4*)(resP + o);
                        const f32x4 y = x * alpha + acc[ai][bj][m][n];
                        if constexpr (OUTB) { u32x2 w; w.x = cvt_pk_bf16(y[0], y[1]); w.y = cvt_pk_bf16(y[2], y[3]); *(u32x2*)(outB + o) = w; } else *(f32x4*)(out + o) = y; } }
    }
};
struct EpiFfn {
    static constexpr bool PERM = true, AFTER_DRAIN = false;
    bf16_t* H; float* GH; float* GF; const float* cw; const float* cb; const float* st; float* pf; float* sf;
    __device__ __forceinline__ void operator()(const f32x4 (&acc)[2][2][4][2], const Unit& u, int wr, int wc, int fr, int fq) const {
        const int lane = fresh_lane();
#pragma unroll
        for (int n = 0; n < 2; ++n) {
            const int col = u.pn * 128 + wc * 32 + 8 * fq + 4 * n;
            const f32x4 w0 = *(const f32x4*)(cw + col), w1 = *(const f32x4*)(cw + 2816 + col), w2 = *(const f32x4*)(cw + 5632 + col), bb = *(const f32x4*)(cb + col);
#pragma unroll
            for (int ai = 0; ai < 2; ++ai) {
                const int rbase = u.pm * BM + ai * HALF + wr * 64; const bool sample = rbase >= 16384; const int span = rbase >> 6;
                f32x4 prev = (f32x4){0.f, 0.f, 0.f, 0.f};
#pragma unroll
                for (int m = 0; m < 4; ++m) {
                    const int row = rbase + 16 * m + fr;
                    const f32x4 cur = acc[ai][0][m][n], val = acc[ai][1][m][n];
                    f32x4 g1, g2;
#pragma unroll
                    for (int e = 0; e < 4; ++e) {
                        const int pr1 = __builtin_amdgcn_update_dpp(0, __float_as_int(prev[e]), 0x121, 0xf, 0xf, false), pr2 = __builtin_amdgcn_update_dpp(0, __float_as_int(prev[e]), 0x122, 0xf, 0xf, false);
                        g1[e] = __int_as_float(__builtin_amdgcn_update_dpp(pr1, __float_as_int(cur[e]), 0x111, 0xf, 0xf, false));
                        g2[e] = __int_as_float(__builtin_amdgcn_update_dpp(pr2, __float_as_int(cur[e]), 0x112, 0xf, 0xf, false)); }
                    bool skip = false;
                    if (sample) {
                        const int t = row & 7, bidx = (row - 16384) >> 3;
                        if (t < 2) { const f32x4 sa = *(const f32x4*)(st + ((size_t)bidx * 2 + 0) * 2816 + col), sb = *(const f32x4*)(st + ((size_t)bidx * 2 + 1) * 2816 + col);
                            if (t == 0) { g1 = sb; g2 = sa; } else { g2 = sb; } }
                        if (t >= 6) *(f32x4*)(sf + ((size_t)bidx * 2 + (t - 6)) * 2816 + col) = cur;
                    } else {
                        if (m == 0 && fr < 2) { skip = true; *(f32x4*)(GF + (((size_t)span * 2 + fr) * 2 + 0) * 2816 + col) = cur; *(f32x4*)(GF + (((size_t)span * 2 + fr) * 2 + 1) * 2816 + col) = val; }
                        if (m == 3 && fr >= 14) { *(f32x4*)(GH + ((size_t)span * 2 + (fr - 14)) * 2816 + col) = cur;
                            if ((row & 2047) >= 2046) *(f32x4*)(pf + ((size_t)(row >> 11) * 2 + (fr - 14)) * 2816 + col) = cur; }
                    }
                    if (!skip) { u32x2 w;
                        const f32x4 x = g2 * w0 + g1 * w1 + cur * w2 + bb;
                        const f32x4 t = x * (x * x * (-0.044715f * 1.5957691216057308f) + (-1.5957691216057308f));
                        f32x4 r; r[0] = __builtin_amdgcn_rcpf(1.0f + __expf(t[0])); r[1] = __builtin_amdgcn_rcpf(1.0f + __expf(t[1])); r[2] = __builtin_amdgcn_rcpf(1.0f + __expf(t[2])); r[3] = __builtin_amdgcn_rcpf(1.0f + __expf(t[3]));
                        const f32x4 hv = x * r * val;
                        w.x = cvt_pk_bf16(hv[0], hv[1]); w.y = cvt_pk_bf16(hv[2], hv[3]); *(u32x2*)(H + (size_t)row * 2816 + col) = w; }
                    prev = cur;
                }
            }
        }
    }
};
template <class Epi, class Sched, bool ALIGN_EPI = false, bool SP2 = false>
__device__ __forceinline__ void gemm_phase(PG8_LAS unsigned char* lds, const Gemm g, const Sched& S, const Epi& E, const int wave_in) {
    int tid = wave_in * 64 + fresh_lane(); asm volatile("" : "+v"(tid));
    const int wid = wave_in, lane = tid & 63, wr = wid >> 2, wc = wid & 3, fr = lane & 15, fq = lane >> 4;
    const int K = g.K;
    unsigned voffA[2], voffB[2];
#pragma unroll
    for (int i = 0; i < 2; ++i) { int R, C; stage_rc(tid * 16 + i * 8192, R, C); const int Rb = Epi::PERM ? ((R & ~31) + perm32(R & 31)) : R;
        voffA[i] = (unsigned)(R * K + C) * 2u; voffB[i] = (unsigned)(Rb * K + C) * 2u; }
    const size_t kstep = (size_t)(BK * 2);
    const size_t hstep = (size_t)HALF * K * 2;
    const size_t tstep = 2 * hstep;
    const unsigned ldsw = (unsigned)wid * 1024u;
    const int aoff = lds_byte(wr * 64 + fr, fq * 8), boff = lds_byte(wc * 32 + fr, fq * 8);
#define PG8_SA(b, h) (((b) * 2 + (h)) * HTB)
#define PG8_SB(b, h) ((4 + (b) * 2 + (h)) * HTB)
#define PG8_STAGE(bufoff, gbase, voff) do { _Pragma("unroll") for (int _i = 0; _i < 2; ++_i) \
        __builtin_amdgcn_global_load_lds((const unsigned*)((const char*)(gbase) + (voff)[_i]), (PG8_LAS unsigned*)(lds + (bufoff) + ldsw + _i * 8192), 16, 0, 0); } while (0)
#define PG8_LDA(dst, b, h) do { _Pragma("unroll") for (int m = 0; m < 4; ++m) _Pragma("unroll") for (int k = 0; k < 2; ++k) dst[m][k] = *(const PG8_LAS bf16x8*)(lds + PG8_SA(b, h) + aoff + m * 2048 + k * 1024); } while (0)
#define PG8_LDB(dst, b, h) do { _Pragma("unroll") for (int n = 0; n < 2; ++n) _Pragma("unroll") for (int k = 0; k < 2; ++k) dst[n][k] = *(const PG8_LAS bf16x8*)(lds + PG8_SB(b, h) + boff + n * 2048 + k * 1024); } while (0)
#define PG8_MMA(ai, bj, At, Bt) do { __builtin_amdgcn_s_setprio(1); _Pragma("unroll") for (int m = 0; m < 4; ++m) _Pragma("unroll") for (int n = 0; n < 2; ++n) _Pragma("unroll") for (int k = 0; k < 2; ++k) \
        acc[ai][bj][m][n] = __builtin_amdgcn_mfma_f32_16x16x32_bf16(Bt[n][k], At[m][k], acc[ai][bj][m][n], 0, 0, 0); __builtin_amdgcn_s_setprio(0); } while (0)
#define PG8_WAIT_V(n) asm volatile("s_waitcnt vmcnt(" #n ")" ::: "memory")
#define PG8_WAIT_L(n) asm volatile("s_waitcnt lgkmcnt(" #n ")" ::: "memory")
#define PG8_BAR __builtin_amdgcn_s_barrier()
#define PG8_SCHED __builtin_amdgcn_sched_barrier(0)
    Unit cur, nxt; int ui = 0;
    if (!S.next(0, cur)) return;
    f32x4 acc[2][2][4][2];
#pragma unroll
    for (int a = 0; a < 2; ++a)
#pragma unroll
        for (int b = 0; b < 2; ++b)
#pragma unroll
            for (int m = 0; m < 4; ++m)
#pragma unroll
                for (int n = 0; n < 2; ++n) acc[a][b][m][n] = (f32x4){0.f, 0.f, 0.f, 0.f};
    bf16x8 At[4][2], B0[2][2], B1[2][2];
    const char* cA = (const char*)g.A + (size_t)cur.pm * tstep + (size_t)cur.k0 * 2; const char* cB = (const char*)g.Bt + (size_t)cur.pn * tstep + (size_t)cur.k0 * 2;
    S.a_ready(cur);
    if constexpr (SP2) {
        PG8_STAGE(PG8_SB(0, 0), cB, voffB); PG8_STAGE(PG8_SB(0, 1), cB + hstep, voffB); PG8_STAGE(PG8_SA(0, 0), cA, voffA); PG8_STAGE(PG8_SA(0, 1), cA + hstep, voffA);
        if (wr == 1) PG8_BAR;
        PG8_WAIT_V(2); PG8_BAR;
        PG8_STAGE(PG8_SB(1, 0), cB + kstep, voffB); PG8_STAGE(PG8_SA(1, 0), cA + kstep, voffA); PG8_STAGE(PG8_SB(1, 1), cB + hstep + kstep, voffB);
        PG8_WAIT_V(6); PG8_BAR;
    } else {
        PG8_STAGE(PG8_SB(0, 0), cB, voffB); PG8_STAGE(PG8_SA(0, 0), cA, voffA); PG8_STAGE(PG8_SB(0, 1), cB + hstep, voffB); PG8_STAGE(PG8_SA(0, 1), cA + hstep, voffA);
        if (wr == 1) PG8_BAR;
        PG8_WAIT_V(4); PG8_BAR;
        PG8_STAGE(PG8_SB(1, 0), cB + kstep, voffB); PG8_STAGE(PG8_SA(1, 0), cA + kstep, voffA); PG8_STAGE(PG8_SB(1, 1), cB + hstep + kstep, voffB);
        PG8_WAIT_V(6); PG8_BAR;
    }
    for (;;) {
        const bool has_next = S.next(ui + 1, nxt);
        const char* nA = has_next ? (const char*)g.A + (size_t)nxt.pm * tstep + (size_t)nxt.k0 * 2 : cA; const char* nB = has_next ? (const char*)g.Bt + (size_t)nxt.pn * tstep + (size_t)nxt.k0 * 2 : cB;
        const int nt = cur.nt;
        for (int t = 0; t < nt; t += 2) {
            const bool last = (t == nt - 2);
            const char* a1 = cA + (size_t)(t + 1) * kstep;
            const char* a2 = last ? nA : cA + (size_t)(t + 2) * kstep; const char* b2 = last ? nB : cB + (size_t)(t + 2) * kstep;
            const char* a3 = a2 + kstep; const char* b3 = b2 + kstep;
            if (last && has_next) S.a_ready(nxt);
            if constexpr (SP2) {
            PG8_LDB(B0, 0, 0); PG8_LDB(B1, 0, 1); PG8_SCHED; PG8_LDA(At, 0, 0); PG8_STAGE(PG8_SA(1, 1), a1 + hstep, voffA);
            PG8_WAIT_V(8); PG8_WAIT_L(0); PG8_BAR; PG8_MMA(0, 0, At, B0); PG8_MMA(0, 1, At, B1); PG8_BAR; PG8_SCHED;
            PG8_LDA(At, 0, 1); PG8_STAGE(PG8_SB(0, 0), b2, voffB); PG8_STAGE(PG8_SB(0, 1), b2 + hstep, voffB); PG8_STAGE(PG8_SA(0, 0), a2, voffA);
            PG8_WAIT_V(8); PG8_WAIT_L(0); PG8_BAR; PG8_MMA(1, 0, At, B0); PG8_MMA(1, 1, At, B1); PG8_BAR; PG8_SCHED;
            PG8_LDB(B0, 1, 0); PG8_LDB(B1, 1, 1); PG8_SCHED; PG8_LDA(At, 1, 0); PG8_STAGE(PG8_SA(0, 1), a2 + hstep, voffA);
            PG8_WAIT_V(8); PG8_WAIT_L(0); PG8_BAR; PG8_MMA(0, 0, At, B0); PG8_MMA(0, 1, At, B1); PG8_BAR; PG8_SCHED;
            PG8_LDA(At, 1, 1); PG8_STAGE(PG8_SB(1, 0), b3, voffB); PG8_STAGE(PG8_SB(1, 1), b3 + hstep, voffB); PG8_STAGE(PG8_SA(1, 0), a3, voffA);
            PG8_WAIT_V(8); PG8_WAIT_L(0); PG8_BAR; PG8_MMA(1, 0, At, B0); PG8_MMA(1, 1, At, B1); PG8_BAR; PG8_SCHED;
            } else {
            PG8_LDB(B0, 0, 0); PG8_SCHED; PG8_LDA(At, 0, 0); PG8_STAGE(PG8_SA(1, 1), a1 + hstep, voffA);
            PG8_WAIT_L(8); PG8_BAR; PG8_WAIT_L(0); PG8_MMA(0, 0, At, B0); PG8_BAR; PG8_SCHED;
            PG8_LDB(B1, 0, 1); PG8_STAGE(PG8_SB(0, 0), b2, voffB);
            PG8_BAR; PG8_WAIT_L(0); PG8_MMA(0, 1, At, B1); PG8_BAR;
            PG8_LDA(At, 0, 1); PG8_STAGE(PG8_SA(0, 0), a2, voffA);
            PG8_BAR; PG8_WAIT_L(0); PG8_MMA(1, 0, At, B0); PG8_BAR; PG8_SCHED;
            PG8_STAGE(PG8_SB(0, 1), b2 + hstep, voffB);
            PG8_WAIT_V(6); PG8_BAR; PG8_MMA(1, 1, At, B1); PG8_BAR;
            PG8_LDB(B0, 1, 0); PG8_SCHED; PG8_LDA(At, 1, 0); PG8_STAGE(PG8_SA(0, 1), a2 + hstep, voffA);
            PG8_WAIT_L(8); PG8_BAR; PG8_WAIT_L(0); PG8_MMA(0, 0, At, B0); PG8_BAR; PG8_SCHED;
            PG8_LDB(B1, 1, 1); PG8_STAGE(PG8_SB(1, 0), b3, voffB);
            PG8_BAR; PG8_WAIT_L(0); PG8_MMA(0, 1, At, B1); PG8_BAR;
            PG8_LDA(At, 1, 1); PG8_STAGE(PG8_SA(1, 0), a3, voffA);
            PG8_BAR; PG8_WAIT_L(0); PG8_MMA(1, 0, At, B0); PG8_BAR; PG8_SCHED;
            PG8_STAGE(PG8_SB(1, 1), b3 + hstep, voffB);
            PG8_WAIT_V(6); PG8_BAR; PG8_MMA(1, 1, At, B1); PG8_BAR;
            }
        }
        if constexpr (ALIGN_EPI) { if (wr == 0) PG8_BAR; }
        if constexpr (!Epi::AFTER_DRAIN) { E(acc, cur, wr, wc, fr, fq); S.done(cur); }
        if (!has_next) break;
#pragma unroll
        for (int a = 0; a < 2; ++a)
#pragma unroll
            for (int b = 0; b < 2; ++b)
#pragma unroll
                for (int m = 0; m < 4; ++m)
#pragma unroll
                    for (int n = 0; n < 2; ++n) acc[a][b][m][n] = (f32x4){0.f, 0.f, 0.f, 0.f};
        cur = nxt; cA = nA; cB = nB; ++ui;
        if constexpr (ALIGN_EPI) { if (wr == 1) PG8_BAR; }
    }
    PG8_WAIT_V(0);
    if constexpr (!ALIGN_EPI) { if (wr == 0) PG8_BAR; }
    PG8_BAR;
    if constexpr (Epi::AFTER_DRAIN) { E.fused(acc, cur, wr, wc, fr, fq, lds, wid, lane); S.done(cur); }
#undef PG8_SA
#undef PG8_SB
#undef PG8_STAGE
#undef PG8_LDA
#undef PG8_LDB
#undef PG8_MMA
#undef PG8_WAIT_V
#undef PG8_WAIT_L
#undef PG8_BAR
#undef PG8_SCHED
}
}
#define LAS __attribute__((address_space(3)))
typedef unsigned short bf16;
typedef short bf16x8 __attribute__((ext_vector_type(8)));
typedef float f32x4 __attribute__((ext_vector_type(4)));
typedef unsigned v4u __attribute__((ext_vector_type(4)));
typedef unsigned v2u __attribute__((ext_vector_type(2)));
constexpr int NWAVES = 8, NTHR = 512;
constexpr int MP = 16384, MS = 1024, M = MP + MS, D = 1024, NPROJ = 3328, DFF = 2816, NUP = 5632, T = 2048;
constexpr int C_QA = 0, C_KA = 384, C_VA = 768, C_ZA = 1152, C_XB = 1536, C_GB = 1792, C_QC = 2048, C_KC = 2240, C_VC = 2432, C_ZC = 2816, C_LC = 3200, C_BA = 3216, C_AA = 3222;
constexpr float ALPHA = 1.4142135623730951f;
constexpr float EPS = 1e-6f;
constexpr size_t O_Y = 0, O_PDCONV = (size_t)M * D, O_PDELTA = O_PDCONV + 2 * 8 * 3 * 1152, O_PLCONV = O_PDELTA + 2 * 8 * 6 * 4096, O_PLRU = O_PLCONV + 2 * 8 * 3 * 256,
    O_PGLA = O_PLRU + 2 * 8 * 256, O_PFCONV = O_PGLA + 2 * 8 * 6 * 2048, O_SDCONV = O_PFCONV + 2 * 8 * 2 * 2816, O_SDELTA = O_SDCONV + 2 * 128 * 3 * 1152,
    O_SLCONV = O_SDELTA + (size_t)2 * 128 * 6 * 4096, O_SLRU = O_SLCONV + 2 * 128 * 3 * 256, O_SGLA = O_SLRU + 2 * 128 * 256, O_SFCONV = O_SGLA + (size_t)2 * 128 * 6 * 2048,
    O_END = O_SFCONV + (size_t)2 * 128 * 2 * 2816;
constexpr size_t MiB = 1u << 20;
constexpr size_t WS_WIN = 1 * MiB, WS_WOUT = WS_WIN + (size_t)NPROJ * D * 2, WS_WUP = WS_WOUT + (size_t)D * D * 2, WS_WDN = WS_WUP + (size_t)NUP * D * 2;
constexpr size_t WS_XN = 26 * MiB;
constexpr size_t WS_R = 60 * MiB;
constexpr size_t WS_PROJ = WS_R;
constexpr size_t WS_DT = 171 * MiB;
constexpr size_t WS_GQ = 231 * MiB, WS_GU = 237 * MiB, WS_GD = 249 * MiB, WS_AB = 250 * MiB, WS_GAM = 251 * MiB;
constexpr size_t WS_H = WS_R, WS_GH = 154 * MiB, WS_GF = 160 * MiB, WS_PART = 210 * MiB, WS_YB1 = WS_R, WS_YB2 = 172 * MiB;
static_assert(WS_WDN + (size_t)D * DFF * 2 <= WS_XN && WS_XN + (size_t)M * D * 2 <= WS_R && WS_PROJ + (size_t)M * NPROJ * 2 <= WS_DT && WS_H + (size_t)M * DFF * 2 <= WS_GH, "ws map");
constexpr int LDS_BYTES = 147456;

__device__ __forceinline__ float bf2f(bf16 v) { return __uint_as_float((unsigned)v << 16); }
__device__ __forceinline__ unsigned f2bf(float f) { unsigned u = __float_as_uint(f); return (u + 0x7fffu + ((u >> 16) & 1u)) >> 16; }
__device__ __forceinline__ unsigned pk2(float lo, float hi) { return f2bf(lo) | (f2bf(hi) << 16); }
__device__ __forceinline__ float shidx(float v, int src) { return __int_as_float(__builtin_amdgcn_ds_bpermute(src << 2, __float_as_int(v))); }
__device__ __forceinline__ float shx(float v, int o, int lane) { return shidx(v, lane ^ o); }
__device__ __forceinline__ float wave_sum(float v, int lane) {
#pragma unroll
    for (int o = 1; o < 64; o <<= 1) v += shx(v, o, lane);
    return v;
}
__device__ __forceinline__ float sigm(float x) { return __builtin_amdgcn_rcpf(1.0f + __expf(-x)); }
__device__ __forceinline__ float siluf(float x) { return x * __builtin_amdgcn_rcpf(1.0f + __expf(-x)); }
__device__ __forceinline__ float softplusf(float x) { return x > 20.f ? x : log1pf(expf(x)); }
__device__ __forceinline__ float gelu_t(float x) { const float t = 1.5957691216057308f * (x + 0.044715f * x * x * x); return x * __builtin_amdgcn_rcpf(1.0f + __expf(-t)); }
__device__ __forceinline__ float rdlane(float v, int l) { return __int_as_float(__builtin_amdgcn_readlane(__float_as_int(v), l)); }
#define LDS_WAIT() asm volatile("s_waitcnt lgkmcnt(0)" ::: "memory")

template <int K> __device__ __forceinline__ f32x4 mma_lds(const LAS bf16* X1, int ld1, const LAS bf16* X2, int ld2, f32x4 acc, int lane) {
    const int r = lane & 15, q8 = (lane >> 4) * 8;
#pragma unroll
    for (int k0 = 0; k0 < K; k0 += 32) {
        const bf16x8 a = *(const LAS bf16x8*)(X1 + r * ld1 + k0 + q8);
        const bf16x8 b = *(const LAS bf16x8*)(X2 + r * ld2 + k0 + q8);
        acc = __builtin_amdgcn_mfma_f32_16x16x32_bf16(a, b, acc, 0, 0, 0);
    }
    return acc;
}

struct Args { const float* in[32]; float* out; unsigned char* ws; };
typedef const __attribute__((address_space(4))) Args CA;

__device__ __forceinline__ void transpose_item(const float* W, int K, int Nsrc, int mode, bf16* WT, LAS float* scr, int item, int nblk, int lane) {
    const int kb = item / nblk, nb = item % nblk, k0 = 64 * kb, n0 = 32 * nb;
    const int n = n0 + (lane & 31); int sc;
    if (mode == 0) sc = n;
    else if (mode == 1) sc = n < 1536 ? n : (n < 3216 ? n + 12 : (n < 3228 ? n - 1680 : -1));
    else { const int j = n & 255, pn = n >> 8; sc = j < 128 ? pn * 128 + j : 2816 + pn * 128 + (j - 128); }
#pragma unroll 8
    for (int i = 0; i < 32; ++i) { const int kk = 2 * i + (lane >> 5); scr[kk * 33 + (lane & 31)] = sc >= 0 ? W[(size_t)(k0 + kk) * Nsrc + sc] : 0.f; }
    LDS_WAIT();
    const int c = lane & 7;
#pragma unroll
    for (int j = 0; j < 4; ++j) { const int nn = (lane >> 3) + 8 * j; const LAS float* s = scr + (8 * c) * 33 + nn;
        v4u o; o.x = pk2(s[0 * 33], s[1 * 33]); o.y = pk2(s[2 * 33], s[3 * 33]); o.z = pk2(s[4 * 33], s[5 * 33]); o.w = pk2(s[6 * 33], s[7 * 33]);
        *(v4u*)(WT + (size_t)(n0 + nn) * K + k0 + 8 * c) = o; }
    LDS_WAIT();
}
__device__ __forceinline__ void convert_item(CA& A, LAS float* scr, int l, int it, int lane) {
    constexpr int I1 = 16 * 104, I2 = 16 * 32, I3 = 16 * 176;
    int r = it;
    if (r < I1) { transpose_item(A.in[8] + (size_t)l * D * 3228, D, 3228, 1, (bf16*)(A.ws + WS_WIN), scr, r, 104, lane); return; } r -= I1;
    if (r < I2) { transpose_item(A.in[23] + (size_t)l * D * D, D, D, 0, (bf16*)(A.ws + WS_WOUT), scr, r, 32, lane); return; } r -= I2;
    if (r < I3) { transpose_item(A.in[26] + (size_t)l * D * NUP, D, NUP, 2, (bf16*)(A.ws + WS_WUP), scr, r, 176, lane); return; } r -= I3;
    transpose_item(A.in[29] + (size_t)l * DFF * D, DFF, D, 0, (bf16*)(A.ws + WS_WDN), scr, r, 32, lane);
}
constexpr int CONV_A = 16 * 104 + 16 * 32 + 16 * 176, CONV_ALL = CONV_A + 44 * 32;
__device__ __forceinline__ void convert_weights(CA& A, LAS unsigned char* lds, int l, int first, int last, int gw, int NGW, int wave, int lane) {
    LAS float* scr = (LAS float*)(lds + wave * 16384);
    for (int it = first + gw; it < last; it += NGW) convert_item(A, scr, l, it, lane);
}
__device__ __forceinline__ void convert_weights_queue(CA& A, LAS unsigned char* lds, int l, unsigned* ctr, int wave, int lane) {
    LAS float* scr = (LAS float*)(lds + wave * 16384);
    for (;;) {
        unsigned it = 0u; if (lane == 0) it = __hip_atomic_fetch_add(ctr, 1u, __ATOMIC_RELAXED, __HIP_MEMORY_SCOPE_AGENT);
        it = (unsigned)__builtin_amdgcn_readfirstlane((int)it);
        if (it >= (unsigned)CONV_A) break;
        convert_item(A, scr, l, (int)it, lane);
    }
}
__device__ __forceinline__ void x_to_bf16(CA& A, int gw, int NGW, int lane) {
    bf16* XN = (bf16*)(A.ws + WS_XN);
    for (int m = gw; m < M; m += NGW) {
        const float* xr = m < MP ? A.in[0] + (size_t)m * D : A.in[1] + (size_t)(m - MP) * D;
        const f32x4* x4 = (const f32x4*)xr + lane; v2u* o = (v2u*)(XN + (size_t)m * D) + lane;
#pragma unroll
        for (int j = 0; j < 4; ++j) { const f32x4 v = x4[64 * j]; v2u w; w.x = pk2(v[0], v[1]); w.y = pk2(v[2], v[3]); o[64 * j] = w;
            if (m >= MP) ((f32x4*)(A.out + (size_t)m * D) + lane)[64 * j] = v * ALPHA; }
    }
}
template <int nsplit, bool INB> __device__ __forceinline__ void ln_load(CA& A, const float* part, const bf16* yb, int m, int lane, f32x4 (&v)[4]) {
    const f32x4* x4 = (const f32x4*)(A.out + (size_t)m * D) + lane;
    if (INB && m < MP) { const v2u* y2 = (const v2u*)(yb + (size_t)m * D) + lane;
#pragma unroll
        for (int j = 0; j < 4; ++j) { const v2u w = y2[64 * j]; v[j] = (f32x4){__uint_as_float(w.x << 16), __uint_as_float(w.x & 0xffff0000u), __uint_as_float(w.y << 16), __uint_as_float(w.y & 0xffff0000u)}; }
    } else {
#pragma unroll
        for (int j = 0; j < 4; ++j) v[j] = x4[64 * j]; }
    if (m >= MP) { const int pmq = (m - MP) >> 8, r = (m - MP) & 255;
#pragma unroll
        for (int j = 0; j < 4; ++j) { const float* pp = part + (size_t)((pmq * 4 + j) * nsplit) * 65536 + (size_t)r * 256 + 4 * lane;
            f32x4 pv[nsplit];
#pragma unroll
            for (int ks = 0; ks < nsplit; ++ks) pv[ks] = *(const f32x4*)(pp + (size_t)ks * 65536);
#pragma unroll
            for (int ks = 0; ks < nsplit; ++ks) v[j] = v[j] + pv[ks]; } }
}
template <bool WXN> __device__ __forceinline__ void ln_finish(CA& A, const float* g, const float* b, bool prescale, bool f32_prompt, int m, int lane, f32x4 (&v)[4]) {
    f32x4* x4 = (f32x4*)(A.out + (size_t)m * D) + lane; v2u* o = (v2u*)((bf16*)(A.ws + WS_XN) + (size_t)m * D) + lane;
    float s = 0.f;
#pragma unroll
    for (int j = 0; j < 4; ++j) s += (v[j][0] + v[j][1]) + (v[j][2] + v[j][3]);
    const float mean = wave_sum(s, lane) * (1.f / D); float s2 = 0.f;
#pragma unroll
    for (int j = 0; j < 4; ++j) { v[j] = v[j] - mean; s2 += (v[j][0] * v[j][0] + v[j][1] * v[j][1]) + (v[j][2] * v[j][2] + v[j][3] * v[j][3]); }
    const float rstd = 1.0f / sqrtf(wave_sum(s2, lane) * (1.f / D) + EPS);
#pragma unroll
    for (int j = 0; j < 4; ++j) { const f32x4 gg = *((const f32x4*)g + lane + 64 * j), bb = *((const f32x4*)b + lane + 64 * j);
        const f32x4 y = v[j] * rstd * gg + bb; if (f32_prompt || m >= MP) x4[64 * j] = (prescale && m >= MP) ? y * ALPHA : y;
        if constexpr (WXN) { v2u w; w.x = pk2(y[0], y[1]); w.y = pk2(y[2], y[3]); o[64 * j] = w; } }
}
template <int nsplit, bool INB, bool WXN> __device__ __forceinline__ void ln_pass(CA& A, const float* g, const float* b, bool prescale, bool f32_prompt, const float* part, const bf16* yb, int gw, int NGW, int lane) {
    for (int m = gw; m < M; m += 2 * NGW) {
        const int m2 = m + NGW; const bool two = m2 < M;
        f32x4 va[4], vb[4];
        ln_load<nsplit, INB>(A, part, yb, m, lane, va);
        if (two) ln_load<nsplit, INB>(A, part, yb, m2, lane, vb);
        ln_finish<WXN>(A, g, b, prescale, f32_prompt, m, lane, va);
        if (two) ln_finish<WXN>(A, g, b, prescale, f32_prompt, m2, lane, vb);
    }
}

__device__ __forceinline__ void sample_delta_item(CA& A, int l, int item, int lane) {
    const int h = item % 6, b = item / 6;
    const bf16* PROJ = (const bf16*)(A.ws + WS_PROJ); bf16* HEADS = (bf16*)(A.ws + WS_XN);
    const size_t row0 = (size_t)MP + b * 8;
    float S[64];
    const float* S0 = A.in[3] + (((size_t)l * 128 + b) * 6 + h) * 4096 + lane;
#pragma unroll
    for (int k = 0; k < 64; ++k) S[k] = S0[k * 64];
    const float* cs = A.in[2] + ((size_t)l * 128 + b) * 3 * 1152; const float* cwp = A.in[9] + (size_t)l * 4 * 1152;
    const int cq = h * 64 + lane, ck = 384 + cq, cv = 768 + cq;
    const float wq0 = cwp[cq], wq1 = cwp[1152 + cq], wq2 = cwp[2304 + cq], wq3 = cwp[3456 + cq];
    const float wk0 = cwp[ck], wk1 = cwp[1152 + ck], wk2 = cwp[2304 + ck], wk3 = cwp[3456 + ck];
    const float wv0 = cwp[cv], wv1 = cwp[1152 + cv], wv2 = cwp[2304 + cv], wv3 = cwp[3456 + cv];
    float q0 = cs[cq], q1 = cs[1152 + cq], q2 = cs[2304 + cq], k0 = cs[ck], k1 = cs[1152 + ck], k2 = cs[2304 + ck], v0 = cs[cv], v1 = cs[1152 + cv], v2 = cs[2304 + cv];
    const float ae = expf(A.in[10][l * 6 + h]), dtb = A.in[11][l * 6 + h], nw = A.in[12][l * 64 + lane];
#pragma unroll 1
    for (int t = 0; t < 8; ++t) {
        const size_t row = row0 + t; const bf16* pr = PROJ + row * NPROJ;
        const float pq = bf2f(pr[cq]), pk = bf2f(pr[ck]), pv = bf2f(pr[cv]);
        const float qv = siluf(q0 * wq0 + q1 * wq1 + q2 * wq2 + pq * wq3), kv = siluf(k0 * wk0 + k1 * wk1 + k2 * wk2 + pk * wk3), vv = siluf(v0 * wv0 + v1 * wv1 + v2 * wv2 + pv * wv3);
        q0 = q1; q1 = q2; q2 = pq; k0 = k1; k1 = k2; k2 = pk; v0 = v1; v1 = v2; v2 = pv;
        const float rq = rsqrtf(wave_sum(qv * qv, lane) + EPS) * 0.125f, rk = rsqrtf(wave_sum(kv * kv, lane) + EPS);
        const float qn = qv * rq, kn = kv * rk;
        const float beta = sigm(bf2f(pr[C_BA + h]));
        const float a = expf(-ae * softplusf(bf2f(pr[C_AA + h]) + dtb));
        float kS = 0.f;
#pragma unroll
        for (int k = 0; k < 64; ++k) kS += rdlane(kn, k) * S[k];
        const float dv = beta * (vv - a * kS);
        float o = 0.f;
#pragma unroll
        for (int k = 0; k < 64; ++k) { S[k] = a * S[k] + rdlane(kn, k) * dv; o += rdlane(qn, k) * S[k]; }
        const float rinv = rsqrtf(wave_sum(o * o, lane) * (1.f / 64.f) + EPS);
        const float z = bf2f(pr[C_ZA + h * 64 + lane]);
        HEADS[row * D + h * 64 + lane] = (bf16)f2bf(o * rinv * nw * siluf(z));
    }
    float* dc = A.out + O_SDCONV + ((size_t)l * 128 + b) * 3 * 1152;
    dc[cq] = q0; dc[1152 + cq] = q1; dc[2304 + cq] = q2; dc[ck] = k0; dc[1152 + ck] = k1; dc[2304 + ck] = k2; dc[cv] = v0; dc[1152 + cv] = v1; dc[2304 + cv] = v2;
    int lane2 = lane; asm volatile("" : "+v"(lane2));
    float* So = A.out + O_SDELTA + (((size_t)l * 128 + b) * 6 + h) * 4096 + lane2;
#pragma unroll
    for (int k = 0; k < 64; ++k) So[k * 64] = S[k];
}
__device__ __forceinline__ void sample_gla_item(CA& A, int l, int item, int lane) {
    const int h = item % 6, b = item / 6;
    const bf16* PROJ = (const bf16*)(A.ws + WS_PROJ); bf16* HEADS = (bf16*)(A.ws + WS_XN);
    const size_t row0 = (size_t)MP + b * 8;
    float S[32];
    const float* S0 = A.in[6] + (((size_t)l * 128 + b) * 6 + h) * 2048 + lane;
#pragma unroll
    for (int k = 0; k < 32; ++k) S[k] = S0[k * 64];
    const int kl = lane & 31;
    float w2[16];
#pragma unroll
    for (int r = 0; r < 16; ++r) w2[r] = A.in[20][((size_t)l * 16 + r) * 192 + h * 32 + kl];
    const float b2 = A.in[21][l * 192 + h * 32 + kl], nw = A.in[22][l * 64 + lane];
#pragma unroll 1
    for (int t = 0; t < 8; ++t) {
        const size_t row = row0 + t;
        float lg = b2;
#pragma unroll
        for (int r = 0; r < 16; ++r) lg += bf2f(PROJ[row * NPROJ + C_LC + r]) * w2[r];
        const float f = expf(-softplusf(-lg) * (1.f / 16.f));
        const float qk_ = bf2f(PROJ[row * NPROJ + C_QC + h * 32 + kl]) * 0.17677669529663687f, kk_ = bf2f(PROJ[row * NPROJ + C_KC + h * 32 + kl]);
        const float v = bf2f(PROJ[row * NPROJ + C_VC + h * 64 + lane]);
        float o = 0.f;
#pragma unroll
        for (int k = 0; k < 32; ++k) { S[k] = rdlane(f, k) * S[k] + rdlane(kk_, k) * v; o += rdlane(qk_, k) * S[k]; }
        const float rinv = rsqrtf(wave_sum(o * o, lane) * (1.f / 64.f) + EPS);
        const float z = bf2f(PROJ[row * NPROJ + C_ZC + h * 64 + lane]);
        HEADS[row * D + 640 + h * 64 + lane] = (bf16)f2bf(o * rinv * nw * siluf(z));
    }
    int lane2 = lane; asm volatile("" : "+v"(lane2));
    float* So = A.out + O_SGLA + (((size_t)l * 128 + b) * 6 + h) * 2048 + lane2;
#pragma unroll
    for (int k = 0; k < 32; ++k) So[k * 64] = S[k];
}

__device__ __forceinline__ void m1_delta_pair(CA& A, LAS unsigned char* lds, int l, int u, int tid, int lane, int wave) {
    constexpr int SUBB = 69632;
    const int item0 = 2 * u, bh = item0 >> 5, c0 = item0 & 31, b = bh / 6, h = bh % 6;
    const bf16* PROJ = (const bf16*)(A.ws + WS_PROJ);
    bf16* DT = (bf16*)(A.ws + WS_DT); constexpr size_t TS = (size_t)1536 * 4096;
    const float* cwp = A.in[9] + (size_t)l * 4 * 1152;
#pragma unroll
    for (int sub = 0; sub < 2; ++sub) {
        LAS float* Qf = (LAS float*)(lds + sub * SUBB); LAS float* Kf = Qf + 64 * 65; LAS float* Vf = Kf + 64 * 65;
        const int c = c0 + sub; const long row0 = (long)b * T + c * 64;
        const int ch = tid & 63, g = tid >> 6;
#pragma unroll
        for (int ten = 0; ten < 3; ++ten) {
            const int col = ten * 384 + h * 64 + ch;
            const float w0 = cwp[col], w1 = cwp[1152 + col], w2 = cwp[2304 + col], w3 = cwp[3456 + col];
            float x[11];
#pragma unroll
            for (int r = 0; r < 11; ++r) { const int i = 8 * g - 3 + r; x[r] = (c * 64 + i >= 0) ? bf2f(PROJ[(size_t)(row0 + i) * NPROJ + col]) : 0.f; }
            LAS float* dst = ten == 0 ? Qf : (ten == 1 ? Kf : Vf);
#pragma unroll
            for (int j = 0; j < 8; ++j) dst[(8 * g + j) * 65 + ch] = siluf(x[j] * w0 + x[j + 1] * w1 + x[j + 2] * w2 + x[j + 3] * w3);
        }
    }
    if (tid < 128) {
        const int sub = tid >> 6, i = tid & 63; LAS float* Gs = (LAS float*)(lds + sub * SUBB + 68352); LAS float* BETA = Gs + 64;
        const size_t pr = (size_t)((long)b * T + (c0 + sub) * 64 + i) * NPROJ;
        BETA[i] = sigm(bf2f(PROJ[pr + C_BA + h])); Gs[i] = -expf(A.in[10][l * 6 + h]) * softplusf(bf2f(PROJ[pr + C_AA + h]) + A.in[11][l * 6 + h]); }
    __syncthreads();
    if (wave < 2) { LAS float* Gs = (LAS float*)(lds + wave * SUBB + 68352); LAS float* GC = Gs + 128; float s = Gs[lane];
#pragma unroll
        for (int o = 1; o < 64; o <<= 1) { const float t = shidx(s, (lane - o) & 63); if (lane >= o) s += t; }
        GC[lane] = s; }
#pragma unroll
    for (int sub = 0; sub < 2; ++sub) {
        LAS float* Qf = (LAS float*)(lds + sub * SUBB); LAS float* Kf = Qf + 64 * 65;
        LAS bf16* Kb = (LAS bf16*)(lds + sub * SUBB + 49920); LAS bf16* Qb = Kb + 64 * 72;
        LAS float* Gs = (LAS float*)(lds + sub * SUBB + 68352); LAS float* BETA = Gs + 64; LAS float* RQ = Gs + 192; LAS float* RK = Gs + 256;
        const long row0 = (long)b * T + (c0 + sub) * 64;
        const int i = tid >> 3, p = tid & 7; float q[8], k[8], sq = 0.f, sk = 0.f;
#pragma unroll
        for (int d = 0; d < 8; ++d) { q[d] = Qf[i * 65 + 8 * p + d]; k[d] = Kf[i * 65 + 8 * p + d]; sq += q[d] * q[d]; sk += k[d] * k[d]; }
        sq += shx(sq, 1, lane); sq += shx(sq, 2, lane); sq += shx(sq, 4, lane);
        sk += shx(sk, 1, lane); sk += shx(sk, 2, lane); sk += shx(sk, 4, lane);
        const float rq = rsqrtf(sq + EPS) * 0.125f, rk = rsqrtf(sk + EPS);
        v4u wq, wk; wq.x = pk2(q[0] * rq, q[1] * rq); wq.y = pk2(q[2] * rq, q[3] * rq); wq.z = pk2(q[4] * rq, q[5] * rq); wq.w = pk2(q[6] * rq, q[7] * rq);
        wk.x = pk2(k[0] * rk, k[1] * rk); wk.y = pk2(k[2] * rk, k[3] * rk); wk.z = pk2(k[4] * rk, k[5] * rk); wk.w = pk2(k[6] * rk, k[7] * rk);
        *(LAS v4u*)(Qb + i * 72 + 8 * p) = wq; *(LAS v4u*)(Kb + i * 72 + 8 * p) = wk;
        if (p == 0) { RQ[i] = rq; RK[i] = rk; }
    }
    __syncthreads();
    f32x4 Lt_[4];
#pragma unroll
    for (int s = 0; s < 8; ++s) {
        const int t = wave + 8 * s, sub = t >> 5, kind = (t >> 4) & 1, at = (t >> 2) & 3, bt = t & 3;
        LAS bf16* Kb = (LAS bf16*)(lds + sub * SUBB + 49920); LAS bf16* Qb = Kb + 64 * 72;
        LAS float* Gs = (LAS float*)(lds + sub * SUBB + 68352); LAS float* BETA = Gs + 64; LAS float* GC = Gs + 128;
        const int i = 16 * bt + (lane & 15), j0 = 16 * at + 4 * (lane >> 4);
        f32x4 acc = (f32x4){0.f, 0.f, 0.f, 0.f};
        if (at <= bt) acc = mma_lds<64>(Kb + at * 16 * 72, 72, (kind ? Qb : Kb) + bt * 16 * 72, 72, acc, lane);
        const float gi = GC[i];
        if (kind == 0) { const float bi = BETA[i]; f32x4 o;
#pragma unroll
            for (int e = 0; e < 4; ++e) { const int j = j0 + e; o[e] = (j < i) ? bi * acc[e] * __expf(gi - GC[j]) : 0.f; }
            Lt_[(s & 1) + 2 * (s >> 2)] = o;
        } else { float o[4];
#pragma unroll
            for (int e = 0; e < 4; ++e) { const int j = j0 + e; o[e] = (j <= i) ? acc[e] * __expf(gi - GC[j]) : 0.f; }
            v2u w; w.x = pk2(o[0], o[1]); w.y = pk2(o[2], o[3]); *(v2u*)(DT + 2 * TS + (size_t)(item0 + sub) * 4096 + i * 64 + j0) = w; }
    }
    __syncthreads();
#pragma unroll
    for (int s = 0; s < 8; ++s) {
        const int t = wave + 8 * s, sub = t >> 5, kind = (t >> 4) & 1, at = (t >> 2) & 3, bt = t & 3;
        if (kind == 0) { LAS float* Lm = (LAS float*)(lds + sub * SUBB + 49920); const int i = 16 * bt + (lane & 15), j0 = 16 * at + 4 * (lane >> 4);
            *(LAS f32x4*)(Lm + i * 68 + j0) = Lt_[(s & 1) + 2 * (s >> 2)]; }
    }
    __syncthreads();
    if (wave < 4) {
        const int sub = wave >> 1, cidx = tid & 127, item = item0 + sub;
        LAS float* Qf = (LAS float*)(lds + sub * SUBB); LAS float* Kf = Qf + 64 * 65; LAS float* Vf = Kf + 64 * 65;
        LAS float* Lm = (LAS float*)(lds + sub * SUBB + 49920);
        LAS float* Gs = (LAS float*)(lds + sub * SUBB + 68352); LAS float* BETA = Gs + 64; LAS float* GC = Gs + 128; LAS float* RK = Gs + 256;
        bf16* gWK = DT + (size_t)item * 4096; bf16* gUT = gWK + 4 * TS;
        typedef float f32x2 __attribute__((ext_vector_type(2)));
        f32x2 x2[32];
        if (cidx < 64) {
#pragma unroll
            for (int i = 0; i < 64; ++i) x2[i >> 1][i & 1] = BETA[i] * Vf[i * 65 + cidx];
        } else { const int kc = cidx - 64;
#pragma unroll
            for (int i = 0; i < 64; ++i) x2[i >> 1][i & 1] = BETA[i] * __expf(GC[i]) * RK[i] * Kf[i * 65 + kc]; }
#pragma unroll
        for (int i = 1; i < 64; ++i) { f32x2 s01 = (f32x2){0.f, 0.f}, s23 = s01;
#pragma unroll
            for (int j4 = 0; j4 < (i + 3) / 4; ++j4) { const f32x4 Lv = *(const LAS f32x4*)(Lm + i * 68 + 4 * j4);
                s01 += (f32x2){Lv[0], Lv[1]} * x2[2 * j4]; s23 += (f32x2){Lv[2], Lv[3]} * x2[2 * j4 + 1]; }
            x2[i >> 1][i & 1] -= (s01[0] + s01[1]) + (s23[0] + s23[1]); }
        if (cidx < 64) {
#pragma unroll
            for (int j8 = 0; j8 < 8; ++j8) { v4u w; w.x = pk2(x2[4 * j8][0], x2[4 * j8][1]); w.y = pk2(x2[4 * j8 + 1][0], x2[4 * j8 + 1][1]); w.z = pk2(x2[4 * j8 + 2][0], x2[4 * j8 + 2][1]); w.w = pk2(x2[4 * j8 + 3][0], x2[4 * j8 + 3][1]);
                *(v4u*)(gUT + cidx * 64 + 8 * j8) = w; }
        } else { const int kc = cidx - 64;
#pragma unroll
            for (int j = 0; j < 64; ++j) gWK[j * 64 + kc] = (bf16)f2bf(x2[j >> 1][j & 1]); }
        if (cidx == 0) ((float*)(A.ws + WS_GAM))[item] = __expf(GC[63]);
    } else {
        for (int uu_ = tid - 256; uu_ < 2048; uu_ += 256) {
            const int sub = uu_ >> 10, u2 = uu_ & 1023, item = item0 + sub;
            LAS float* Qf = (LAS float*)(lds + sub * SUBB); LAS float* Kf = Qf + 64 * 65;
            LAS float* Gs = (LAS float*)(lds + sub * SUBB + 68352); LAS float* GC = Gs + 128; LAS float* RQ = Gs + 192; LAS float* RK = Gs + 256;
            bf16* gQT = DT + TS + (size_t)item * 4096; bf16* gKDT = DT + 3 * TS + (size_t)item * 4096;
            const float gl = GC[63];
            if (u2 < 512) { const int i = u2 >> 3, k8 = (u2 & 7) * 8; const float sc = RQ[i] * __expf(GC[i]); float q[8];
#pragma unroll
                for (int d = 0; d < 8; ++d) q[d] = Qf[i * 65 + k8 + d] * sc;
                v4u w; w.x = pk2(q[0], q[1]); w.y = pk2(q[2], q[3]); w.z = pk2(q[4], q[5]); w.w = pk2(q[6], q[7]); *(v4u*)(gQT + i * 64 + k8) = w;
            } else { const int uu = u2 - 512, k = uu >> 3, j8 = (uu & 7) * 8; float q[8];
#pragma unroll
                for (int d = 0; d < 8; ++d) { const int j = j8 + d; q[d] = Kf[j * 65 + k] * RK[j] * __expf(gl - GC[j]); }
                v4u w; w.x = pk2(q[0], q[1]); w.y = pk2(q[2], q[3]); w.z = pk2(q[4], q[5]); w.w = pk2(q[6], q[7]); *(v4u*)(gKDT + k * 64 + j8) = w; }
        }
        if (c0 == 30 && tid >= 256 && tid < 448) { const int t2 = tid - 256, ten = t2 >> 6, col = ten * 384 + h * 64 + (t2 & 63); const long rl = (long)b * T + 2045;
#pragma unroll
            for (int r = 0; r < 3; ++r) A.out[O_PDCONV + (((size_t)l * 8 + b) * 3 + r) * 1152 + col] = bf2f(PROJ[(size_t)(rl + r) * NPROJ + col]); }
    }
    __syncthreads();
}

__device__ __forceinline__ void m1_gla_pair(CA& A, LAS unsigned char* lds, int l, int u, int tid, int lane, int wave) {
    constexpr int SUBB = 46080;
    const int item0 = 2 * u, bh = item0 >> 5, c0 = item0 & 31, b = bh / 6, h = bh % 6;
    const bf16* PROJ = (const bf16*)(A.ws + WS_PROJ); bf16* HEADS = (bf16*)(A.ws + WS_XN);
    const int i = tid >> 3, p = tid & 7;
    f32x4 w2v[16];
#pragma unroll
    for (int r = 0; r < 16; ++r) w2v[r] = *(const f32x4*)(A.in[20] + ((size_t)l * 16 + r) * 192 + h * 32 + 4 * p);
    const f32x4 b2v = *(const f32x4*)(A.in[21] + l * 192 + h * 32 + 4 * p);
#pragma unroll
    for (int sub = 0; sub < 2; ++sub) {
        LAS float* BC = (LAS float*)(lds + sub * SUBB + 2304);
        const size_t pr = ((size_t)b * T + (c0 + sub) * 64 + i) * NPROJ;
        float lc[16];
        const v4u l0 = *(const v4u*)(PROJ + pr + C_LC), l1 = *(const v4u*)(PROJ + pr + C_LC + 8);
        const unsigned lw[8] = {l0.x, l0.y, l0.z, l0.w, l1.x, l1.y, l1.z, l1.w};
#pragma unroll
        for (int r = 0; r < 8; ++r) { lc[2 * r] = __uint_as_float(lw[r] << 16); lc[2 * r + 1] = __uint_as_float(lw[r] & 0xffff0000u); }
#pragma unroll
        for (int d = 0; d < 4; ++d) { const int k = 4 * p + d; float lg = b2v[d];
#pragma unroll
            for (int r = 0; r < 16; ++r) lg += lc[r] * w2v[r][d];
            BC[i * 33 + k] = -softplusf(-lg) * (1.f / 16.f); }
    }
    __syncthreads();
    { const int k = tid & 31, sg = tid >> 5;
#pragma unroll
      for (int sub = 0; sub < 2; ++sub) { LAS float* BC = (LAS float*)(lds + sub * SUBB + 2304); LAS float* SEG = (LAS float*)(lds + sub * SUBB + 44032);
          SEG[sg * 32 + k] = (BC[(4 * sg) * 33 + k] + BC[(4 * sg + 1) * 33 + k]) + (BC[(4 * sg + 2) * 33 + k] + BC[(4 * sg + 3) * 33 + k]); } }
    __syncthreads();
#pragma unroll
    for (int sub = 0; sub < 2; ++sub) {
        const int item = item0 + sub;
        bf16* gQ = (bf16*)(A.ws + WS_GQ) + (size_t)item * 2048; float* gD = (float*)(A.ws + WS_GD) + (size_t)item * 32;
        LAS float* BC = (LAS float*)(lds + sub * SUBB + 2304); LAS float* SEG = (LAS float*)(lds + sub * SUBB + 44032);
        LAS bf16* Qb = (LAS bf16*)(lds + sub * SUBB + 10752); LAS bf16* Kb = (LAS bf16*)(lds + sub * SUBB + 15872); LAS bf16* KDt = (LAS bf16*)(lds + sub * SUBB + 20992); LAS bf16* Vt = (LAS bf16*)(lds + sub * SUBB + 25600);
        const size_t pr = ((size_t)b * T + (c0 + sub) * 64 + i) * NPROJ;
        const v2u qw = *(const v2u*)(PROJ + pr + C_QC + h * 32 + 4 * p), kw = *(const v2u*)(PROJ + pr + C_KC + h * 32 + 4 * p);
        const float qv[4] = {__uint_as_float(qw.x << 16), __uint_as_float(qw.x & 0xffff0000u), __uint_as_float(qw.y << 16), __uint_as_float(qw.y & 0xffff0000u)};
        const float kv[4] = {__uint_as_float(kw.x << 16), __uint_as_float(kw.x & 0xffff0000u), __uint_as_float(kw.y << 16), __uint_as_float(kw.y & 0xffff0000u)};
        float qt[4], kt[4];
#pragma unroll
        for (int d = 0; d < 4; ++d) { const int k = 4 * p + d; float bb = 0.f, bl = 0.f;
#pragma unroll
            for (int q = 0; q < 16; ++q) { const float sq = SEG[q * 32 + k]; bl += sq; if (q < (i >> 2)) bb += sq; }
#pragma unroll
            for (int q = 0; q < 4; ++q) { const float f = BC[(4 * (i >> 2) + q) * 33 + k]; if (q <= (i & 3)) bb += f; }
            qt[d] = qv[d] * 0.17677669529663687f * __expf(bb); kt[d] = kv[d] * __expf(-bb); KDt[k * 72 + i] = (bf16)f2bf(kv[d] * __expf(bl - bb)); }
        v2u w; w.x = pk2(qt[0], qt[1]); w.y = pk2(qt[2], qt[3]); *(LAS v2u*)(Qb + i * 40 + 4 * p) = w; *(v2u*)(gQ + i * 32 + 4 * p) = w;
        w.x = pk2(kt[0], kt[1]); w.y = pk2(kt[2], kt[3]); *(LAS v2u*)(Kb + i * 40 + 4 * p) = w;
        const v4u vw = *(const v4u*)(PROJ + pr + C_VC + h * 64 + 8 * p); const unsigned vws[4] = {vw.x, vw.y, vw.z, vw.w};
#pragma unroll
        for (int d = 0; d < 4; ++d) { Vt[(8 * p + 2 * d) * 72 + i] = (bf16)(vws[d] & 0xffffu); Vt[(8 * p + 2 * d + 1) * 72 + i] = (bf16)(vws[d] >> 16); }
        if (tid < 32) { float tl = 0.f;
#pragma unroll
            for (int q = 0; q < 16; ++q) tl += SEG[q * 32 + tid];
            gD[tid] = __expf(tl); }
    }
    __syncthreads();
#pragma unroll
    for (int s = 0; s < 4; ++s) {
        const int t = 4 * wave + s, sub = t >> 4, at = (t >> 2) & 3, bt = t & 3; const int ii = 16 * bt + (lane & 15), j0 = 16 * at + 4 * (lane >> 4);
        LAS bf16* Qb = (LAS bf16*)(lds + sub * SUBB + 10752); LAS bf16* Kb = (LAS bf16*)(lds + sub * SUBB + 15872); LAS bf16* ATb = (LAS bf16*)(lds + sub * SUBB + 34816);
        f32x4 acc = (f32x4){0.f, 0.f, 0.f, 0.f};
        if (at <= bt) acc = mma_lds<32>(Kb + at * 16 * 40, 40, Qb + bt * 16 * 40, 40, acc, lane);
        float o[4];
#pragma unroll
        for (int e = 0; e < 4; ++e) o[e] = (j0 + e <= ii) ? acc[e] : 0.f;
        v2u w; w.x = pk2(o[0], o[1]); w.y = pk2(o[2], o[3]); *(LAS v2u*)(ATb + ii * 72 + j0) = w;
    }
    __syncthreads();
#pragma unroll
    for (int s = 0; s < 4; ++s) {
        const int t = 4 * wave + s, sub = t >> 4, at = (t >> 2) & 3, bt = t & 3; const int ii = 16 * bt + (lane & 15), v0 = 16 * at + 4 * (lane >> 4);
        LAS bf16* Vt = (LAS bf16*)(lds + sub * SUBB + 25600); LAS bf16* ATb = (LAS bf16*)(lds + sub * SUBB + 34816);
        f32x4 acc = (f32x4){0.f, 0.f, 0.f, 0.f};
        acc = mma_lds<64>(Vt + at * 16 * 72, 72, ATb + bt * 16 * 72, 72, acc, lane);
        v2u w; w.x = pk2(acc[0], acc[1]); w.y = pk2(acc[2], acc[3]); *(v2u*)(HEADS + ((size_t)b * T + (c0 + sub) * 64 + ii) * D + 640 + h * 64 + v0) = w;
    }
#pragma unroll
    for (int s = 0; s < 2; ++s) {
        const int t = 2 * wave + s, sub = t >> 3, at = (t >> 2) & 1, bt = t & 3; const int v = 16 * bt + (lane & 15), k0 = 16 * at + 4 * (lane >> 4);
        LAS bf16* KDt = (LAS bf16*)(lds + sub * SUBB + 20992); LAS bf16* Vt = (LAS bf16*)(lds + sub * SUBB + 25600);
        float* gU = (float*)(A.ws + WS_GU) + (size_t)(item0 + sub) * 2048;
        f32x4 acc = (f32x4){0.f, 0.f, 0.f, 0.f};
        acc = mma_lds<64>(KDt + at * 16 * 72, 72, Vt + bt * 16 * 72, 72, acc, lane);
        *(f32x4*)(gU + v * 32 + k0) = acc;
    }
    __syncthreads();
}

__device__ __forceinline__ void m2_delta(CA& A, LAS unsigned char* lds, int l, int bh, int tid, int lane, int wave) {
    const int b = bh / 6, h = bh % 6;
    const bf16* PROJ = (const bf16*)(A.ws + WS_PROJ); bf16* HEADS = (bf16*)(A.ws + WS_XN);
    const bf16* DT = (const bf16*)(A.ws + WS_DT); constexpr size_t TS = (size_t)1536 * 4096; const float* GAM = (const float*)(A.ws + WS_GAM);
    LAS bf16* St = (LAS bf16*)lds;
    LAS bf16* Wt = St + 2 * 4608;
    LAS bf16* TB = Wt + 4608;
    const int lrow = tid >> 3, lc8 = (tid & 7) * 8;
    for (int u = tid; u < 4608 / 2; u += NTHR) ((LAS unsigned*)St)[u] = 0u;
    f32x4 Sreg[4];
#pragma unroll
    for (int kt = 0; kt < 4; ++kt) Sreg[kt] = (f32x4){0.f, 0.f, 0.f, 0.f};
    v4u nx[5];
    { const bf16* src = DT + (size_t)(bh * 32) * 4096 + lrow * 64 + lc8;
#pragma unroll
      for (int q = 0; q < 5; ++q) nx[q] = *(const v4u*)(src + q * TS);
#pragma unroll
      for (int q = 0; q < 5; ++q) *(LAS v4u*)(TB + q * 4608 + lrow * 72 + lc8) = nx[q]; }
    __syncthreads();
    for (int c = 0; c < 32; ++c) {
        const int cur = c & 1, item = bh * 32 + c;
        LAS bf16* Sc = St + cur * 4608; LAS bf16* Sn = St + (cur ^ 1) * 4608;
        LAS bf16* tWK = TB + cur * 5 * 4608; LAS bf16* tQT = tWK + 4608; LAS bf16* tATT = tQT + 4608; LAS bf16* tKDT = tATT + 4608; LAS bf16* tUT = tKDT + 4608;
        if (c + 1 < 32) { const bf16* src = DT + (size_t)(item + 1) * 4096 + lrow * 64 + lc8;
#pragma unroll
            for (int q = 0; q < 5; ++q) nx[q] = *(const v4u*)(src + q * TS); }
        const float gam = GAM[item];
        v2u zpre[4];
        if (wave < 4) { const size_t rowz = (size_t)b * T + c * 64 + 16 * wave + (lane & 15);
#pragma unroll
            for (int vt = 0; vt < 4; ++vt) zpre[vt] = *(const v2u*)(PROJ + rowz * NPROJ + C_ZA + h * 64 + 16 * vt + 4 * (lane >> 4)); }
#pragma unroll
        for (int s = 0; s < 2; ++s) {
            const int t = 2 * wave + s, jt = t & 3, vt = t >> 2;
            f32x4 acc = (f32x4){0.f, 0.f, 0.f, 0.f};
            acc = mma_lds<64>(tWK + jt * 16 * 72, 72, Sc + vt * 16 * 72, 72, acc, lane);
            const int v = 16 * vt + (lane & 15), j0 = 16 * jt + 4 * (lane >> 4);
            const v2u uw = *(const LAS v2u*)(tUT + v * 72 + j0);
            const float w0 = __uint_as_float(uw.x << 16) - acc[0], w1 = __uint_as_float(uw.x & 0xffff0000u) - acc[1], w2 = __uint_as_float(uw.y << 16) - acc[2], w3 = __uint_as_float(uw.y & 0xffff0000u) - acc[3];
            v2u w; w.x = pk2(w0, w1); w.y = pk2(w2, w3); *(LAS v2u*)(Wt + v * 72 + j0) = w;
        }
        __syncthreads();
        if (wave < 4) {
            const int it = wave; f32x4 o[4]; float ss = 0.f;
#pragma unroll
            for (int vt = 0; vt < 4; ++vt) { o[vt] = (f32x4){0.f, 0.f, 0.f, 0.f};
                o[vt] = mma_lds<64>(Sc + vt * 16 * 72, 72, tQT + it * 16 * 72, 72, o[vt], lane);
                o[vt] = mma_lds<64>(Wt + vt * 16 * 72, 72, tATT + it * 16 * 72, 72, o[vt], lane);
                ss += (o[vt][0] * o[vt][0] + o[vt][1] * o[vt][1]) + (o[vt][2] * o[vt][2] + o[vt][3] * o[vt][3]); }
            ss += shx(ss, 16, lane); ss += shx(ss, 32, lane);
            const float rinv = rsqrtf(ss * (1.f / 64.f) + EPS);
            const size_t row = (size_t)b * T + c * 64 + 16 * it + (lane & 15);
#pragma unroll
            for (int vt = 0; vt < 4; ++vt) { const int v0 = 16 * vt + 4 * (lane >> 4);
                const v2u zw = zpre[vt]; const f32x4 nw = *(const f32x4*)(A.in[12] + l * 64 + v0);
                const float z0 = __uint_as_float(zw.x << 16), z1 = __uint_as_float(zw.x & 0xffff0000u), z2 = __uint_as_float(zw.y << 16), z3 = __uint_as_float(zw.y & 0xffff0000u);
                v2u w; w.x = pk2(o[vt][0] * rinv * nw[0] * siluf(z0), o[vt][1] * rinv * nw[1] * siluf(z1)); w.y = pk2(o[vt][2] * rinv * nw[2] * siluf(z2), o[vt][3] * rinv * nw[3] * siluf(z3));
                *(v2u*)(HEADS + row * D + h * 64 + v0) = w; }
        } else {
            const int vt = wave - 4, v = 16 * vt + (lane & 15);
#pragma unroll
            for (int kt = 0; kt < 4; ++kt) { Sreg[kt] = Sreg[kt] * gam;
                Sreg[kt] = mma_lds<64>(tKDT + kt * 16 * 72, 72, Wt + vt * 16 * 72, 72, Sreg[kt], lane);
                v2u w; w.x = pk2(Sreg[kt][0], Sreg[kt][1]); w.y = pk2(Sreg[kt][2], Sreg[kt][3]); *(LAS v2u*)(Sn + v * 72 + 16 * kt + 4 * (lane >> 4)) = w; }
        }
        if (c + 1 < 32) { LAS bf16* dst = TB + (cur ^ 1) * 5 * 4608 + lrow * 72 + lc8;
#pragma unroll
            for (int q = 0; q < 5; ++q) *(LAS v4u*)(dst + q * 4608) = nx[q]; }
        __syncthreads();
    }
    if (wave >= 4) { const int vt = wave - 4, v = 16 * vt + (lane & 15); float* So = A.out + O_PDELTA + (((size_t)l * 8 + b) * 6 + h) * 4096;
#pragma unroll
        for (int kt = 0; kt < 4; ++kt)
#pragma unroll
            for (int e = 0; e < 4; ++e) So[(16 * kt + 4 * (lane >> 4) + e) * 64 + v] = Sreg[kt][e]; }
    __syncthreads();
}
__device__ __forceinline__ void m2_gla(CA& A, LAS unsigned char* lds, int l, int bh, int tid, int lane, int wave) {
    const int b = bh / 6, h = bh % 6;
    const bf16* PROJ = (const bf16*)(A.ws + WS_PROJ); bf16* HEADS = (bf16*)(A.ws + WS_XN);
    const bf16* gQ = (const bf16*)(A.ws + WS_GQ) + (size_t)bh * 32 * 2048; const float* gU = (const float*)(A.ws + WS_GU) + (size_t)bh * 32 * 2048; const float* gD = (const float*)(A.ws + WS_GD) + (size_t)bh * 32 * 32;
    LAS bf16* SbB = (LAS bf16*)lds;
    LAS bf16* QbB = SbB + 2 * 64 * 40;
    const int v = tid >> 3, k4 = (tid & 7) * 4;
    f32x4 S = (f32x4){0.f, 0.f, 0.f, 0.f};
    v4u qn = (v4u){0u, 0u, 0u, 0u}; f32x4 un, dn;
    if (tid < 256) qn = *(const v4u*)(gQ + tid * 8);
    un = *(const f32x4*)(gU + v * 32 + k4); dn = *(const f32x4*)(gD + k4);
    const f32x4 nw0 = *(const f32x4*)(A.in[22] + l * 64 + 4 * (lane >> 4)), nw1 = *(const f32x4*)(A.in[22] + l * 64 + 16 + 4 * (lane >> 4)), nw2 = *(const f32x4*)(A.in[22] + l * 64 + 32 + 4 * (lane >> 4)), nw3 = *(const f32x4*)(A.in[22] + l * 64 + 48 + 4 * (lane >> 4));
    v2u on[4], zn[4];
    if (wave < 4) { const size_t row = (size_t)b * T + 16 * wave + (lane & 15);
#pragma unroll
        for (int vt = 0; vt < 4; ++vt) { const int v0 = 16 * vt + 4 * (lane >> 4); on[vt] = *(const v2u*)(HEADS + row * D + 640 + h * 64 + v0); zn[vt] = *(const v2u*)(PROJ + row * NPROJ + C_ZC + h * 64 + v0); } }
    for (int c = 0; c < 32; ++c) {
        const int cur = c & 1; LAS bf16* Sb = SbB + cur * 64 * 40; LAS bf16* Qb = QbB + cur * 64 * 40;
        const v4u qc = qn; const f32x4 uc = un, dc = dn;
        v2u oc[4], zc[4];
#pragma unroll
        for (int vt = 0; vt < 4; ++vt) { oc[vt] = on[vt]; zc[vt] = zn[vt]; }
        if (c + 1 < 32) { if (tid < 256) qn = *(const v4u*)(gQ + (size_t)(c + 1) * 2048 + tid * 8); un = *(const f32x4*)(gU + (size_t)(c + 1) * 2048 + v * 32 + k4); dn = *(const f32x4*)(gD + (c + 1) * 32 + k4);
            if (wave < 4) { const size_t row = (size_t)b * T + (c + 1) * 64 + 16 * wave + (lane & 15);
#pragma unroll
                for (int vt = 0; vt < 4; ++vt) { const int v0 = 16 * vt + 4 * (lane >> 4); on[vt] = *(const v2u*)(HEADS + row * D + 640 + h * 64 + v0); zn[vt] = *(const v2u*)(PROJ + row * NPROJ + C_ZC + h * 64 + v0); } } }
        { v2u w; w.x = pk2(S[0], S[1]); w.y = pk2(S[2], S[3]); *(LAS v2u*)(Sb + v * 40 + k4) = w; }
        if (tid < 256) *(LAS v4u*)(Qb + (tid >> 2) * 40 + (tid & 3) * 8) = qc;
        __syncthreads();
        if (wave < 4) {
            const int it = wave; f32x4 o[4]; float ss = 0.f;
            const size_t row = (size_t)b * T + c * 64 + 16 * it + (lane & 15);
#pragma unroll
            for (int vt = 0; vt < 4; ++vt) {
                o[vt] = (f32x4){__uint_as_float(oc[vt].x << 16), __uint_as_float(oc[vt].x & 0xffff0000u), __uint_as_float(oc[vt].y << 16), __uint_as_float(oc[vt].y & 0xffff0000u)};
                o[vt] = mma_lds<32>(Sb + vt * 16 * 40, 40, Qb + it * 16 * 40, 40, o[vt], lane);
                ss += (o[vt][0] * o[vt][0] + o[vt][1] * o[vt][1]) + (o[vt][2] * o[vt][2] + o[vt][3] * o[vt][3]); }
            ss += shx(ss, 16, lane); ss += shx(ss, 32, lane);
            const float rinv = rsqrtf(ss * (1.f / 64.f) + EPS);
#pragma unroll
            for (int vt = 0; vt < 4; ++vt) { const int v0 = 16 * vt + 4 * (lane >> 4);
                const v2u zw = zc[vt]; const f32x4 nw = vt == 0 ? nw0 : (vt == 1 ? nw1 : (vt == 2 ? nw2 : nw3));
                const float z0 = __uint_as_float(zw.x << 16), z1 = __uint_as_float(zw.x & 0xffff0000u), z2 = __uint_as_float(zw.y << 16), z3 = __uint_as_float(zw.y & 0xffff0000u);
                v2u w; w.x = pk2(o[vt][0] * rinv * nw[0] * siluf(z0), o[vt][1] * rinv * nw[1] * siluf(z1)); w.y = pk2(o[vt][2] * rinv * nw[2] * siluf(z2), o[vt][3] * rinv * nw[3] * siluf(z3));
                *(v2u*)(HEADS + row * D + 640 + h * 64 + v0) = w; }
        }
        S = dc * S + uc;
    }
    float* So = A.out + O_PGLA + (((size_t)l * 8 + b) * 6 + h) * 2048;
#pragma unroll
    for (int e = 0; e < 4; ++e) So[(k4 + e) * 64 + v] = S[e];
    __syncthreads();
}

__device__ __forceinline__ void m2_lru(CA& A, LAS unsigned char* lds, int l, int u, int tid, int lane, int wave) {
    const int b = u >> 2, blk = u & 3, ch = tid & 63, g = tid >> 6, cg = blk * 64 + ch;
    const bf16* PROJ = (const bf16*)(A.ws + WS_PROJ); bf16* HEADS = (bf16*)(A.ws + WS_XN);
    LAS bf16* Wr = (LAS bf16*)lds; LAS bf16* Wi = Wr + 64 * 72; LAS bf16* XCb = Wi + 64 * 72;
    LAS float* XC = (LAS float*)(lds + 27648); LAS float* AA = XC + 64 * 65; LAS float* BX = AA + 64 * 65; LAS float* SEGP = BX + 64 * 65; LAS float* SEGH = SEGP + 512;
#pragma unroll
    for (int j = 0; j < 8; ++j) { const int d = 8 * g + j; const size_t wi_ = (((size_t)l * 4 + blk) * 64 + d) * 64 + ch;
        Wr[ch * 72 + d] = (bf16)f2bf(A.in[15][wi_]); Wi[ch * 72 + d] = (bf16)f2bf(A.in[17][wi_]); }
    const float* cwp = A.in[13] + (size_t)l * 4 * 256;
    const float cw0 = cwp[cg], cw1 = cwp[256 + cg], cw2 = cwp[512 + cg], cw3 = cwp[768 + cg], cbb = A.in[14][l * 256 + cg];
    float gbr[2][4], gbi[2][4], gsp[2][4];
#pragma unroll
    for (int s = 0; s < 2; ++s) { const int e0 = 16 * ((wave >> 2) * 2 + s) + 4 * (lane >> 4);
#pragma unroll
        for (int e = 0; e < 4; ++e) { const int cc = l * 256 + blk * 64 + e0 + e; gbr[s][e] = A.in[16][cc]; gbi[s][e] = A.in[18][cc]; gsp[s][e] = -8.0f * log1pf(expf(-A.in[19][cc])); } }
    float hrun = 0.f;
    float xn[11], gn[8];
    { const long row0 = (long)b * T;
#pragma unroll
      for (int r = 0; r < 11; ++r) { const int i = 8 * g - 3 + r; xn[r] = i >= 0 ? bf2f(PROJ[(size_t)(row0 + i) * NPROJ + C_XB + cg]) : 0.f; }
#pragma unroll
      for (int j = 0; j < 8; ++j) gn[j] = bf2f(PROJ[(size_t)(row0 + 8 * g + j) * NPROJ + C_GB + cg]); }
    __syncthreads();
    for (int c = 0; c < 32; ++c) {
        const long row0 = (long)b * T + c * 64;
        float xc_[8], gbv[8];
#pragma unroll
        for (int j = 0; j < 8; ++j) { xc_[j] = xn[j] * cw0 + xn[j + 1] * cw1 + xn[j + 2] * cw2 + xn[j + 3] * cw3 + cbb; gbv[j] = gn[j]; }
        if (c + 1 < 32) {
#pragma unroll
            for (int r = 0; r < 11; ++r) xn[r] = bf2f(PROJ[(size_t)(row0 + 64 + 8 * g - 3 + r) * NPROJ + C_XB + cg]);
#pragma unroll
            for (int j = 0; j < 8; ++j) gn[j] = bf2f(PROJ[(size_t)(row0 + 64 + 8 * g + j) * NPROJ + C_GB + cg]); }
#pragma unroll
        for (int j = 0; j < 8; ++j) { XC[(8 * g + j) * 65 + ch] = xc_[j]; XCb[(8 * g + j) * 72 + ch] = (bf16)f2bf(xc_[j]); }
        __syncthreads();
        { const int it = wave & 3, i = 16 * it + (lane & 15);
#pragma unroll
          for (int s = 0; s < 2; ++s) { const int et = (wave >> 2) * 2 + s, e0 = 16 * et + 4 * (lane >> 4);
            f32x4 ar = (f32x4){0.f, 0.f, 0.f, 0.f}, ai = ar;
            ar = mma_lds<64>(Wr + et * 16 * 72, 72, XCb + it * 16 * 72, 72, ar, lane);
            ai = mma_lds<64>(Wi + et * 16 * 72, 72, XCb + it * 16 * 72, 72, ai, lane);
#pragma unroll
            for (int e = 0; e < 4; ++e) { const float r = sigm(ar[e] + gbr[s][e]), ig = sigm(ai[e] + gbi[s][e]); const float la = r * gsp[s][e];
                const float a = __expf(la); AA[i * 65 + e0 + e] = a; BX[i * 65 + e0 + e] = __builtin_amdgcn_sqrtf((1.0f - a) * (1.0f + a)) * ig * XC[i * 65 + e0 + e]; } } }
        __syncthreads();
        float av[8], bv[8]; float hl = 0.f, pl = 1.f;
#pragma unroll
        for (int j = 0; j < 8; ++j) { av[j] = AA[(8 * g + j) * 65 + ch]; bv[j] = BX[(8 * g + j) * 65 + ch]; hl = av[j] * hl + bv[j]; pl *= av[j]; }
        SEGP[g * 64 + ch] = pl; SEGH[g * 64 + ch] = hl;
        __syncthreads();
        float hin = hrun, hall = hrun;
#pragma unroll
        for (int q = 0; q < 8; ++q) { const float p = SEGP[q * 64 + ch], hh = SEGH[q * 64 + ch]; hall = p * hall + hh; if (q < g) hin = hall; }
        hrun = hall;
#pragma unroll
        for (int j = 0; j < 8; ++j) { hin = av[j] * hin + bv[j]; HEADS[(size_t)(row0 + 8 * g + j) * D + 384 + cg] = (bf16)f2bf(hin * gelu_t(gbv[j])); }
    }
    if (wave == 0) { A.out[O_PLRU + ((size_t)l * 8 + b) * 256 + cg] = hrun;
#pragma unroll
        for (int r = 0; r < 3; ++r) A.out[O_PLCONV + (((size_t)l * 8 + b) * 3 + r) * 256 + cg] = bf2f(PROJ[((size_t)b * T + 2045 + r) * NPROJ + C_XB + cg]); }
    __syncthreads();
}

__device__ __forceinline__ void lru_sample_wg(CA& A, LAS unsigned char* lds, int l, int u, int tid, int lane, int wave) {
    const int grp = u >> 2, blk = u & 3, ch = tid & 63, g = tid >> 6, cg = blk * 64 + ch, bs = grp * 8 + g;
    const bf16* PROJ = (const bf16*)(A.ws + WS_PROJ); bf16* HEADS = (bf16*)(A.ws + WS_XN);
    LAS bf16* Wr = (LAS bf16*)lds; LAS bf16* Wi = Wr + 64 * 72; LAS bf16* XCb = Wi + 64 * 72;
    LAS float* XC = (LAS float*)(lds + 27648); LAS float* AA = XC + 64 * 65; LAS float* BX = AA + 64 * 65; LAS float* HO = BX + 64 * 65;
#pragma unroll
    for (int j = 0; j < 8; ++j) { const int d = 8 * g + j; const size_t wi_ = (((size_t)l * 4 + blk) * 64 + d) * 64 + ch;
        Wr[ch * 72 + d] = (bf16)f2bf(A.in[15][wi_]); Wi[ch * 72 + d] = (bf16)f2bf(A.in[17][wi_]); }
    const float* cwp = A.in[13] + (size_t)l * 4 * 256;
    const float cw0 = cwp[cg], cw1 = cwp[256 + cg], cw2 = cwp[512 + cg], cw3 = cwp[768 + cg], cbb = A.in[14][l * 256 + cg];
    const size_t row0 = (size_t)MP + grp * 64;
    float xn[11], gbv[8];
    const float* cs = A.in[4] + ((size_t)l * 128 + bs) * 3 * 256;
    xn[0] = cs[cg]; xn[1] = cs[256 + cg]; xn[2] = cs[512 + cg];
#pragma unroll
    for (int j = 0; j < 8; ++j) { xn[3 + j] = bf2f(PROJ[(row0 + 8 * g + j) * NPROJ + C_XB + cg]); gbv[j] = bf2f(PROJ[(row0 + 8 * g + j) * NPROJ + C_GB + cg]); }
#pragma unroll
    for (int j = 0; j < 8; ++j) { const float xc = xn[j] * cw0 + xn[j + 1] * cw1 + xn[j + 2] * cw2 + xn[j + 3] * cw3 + cbb; XC[(8 * g + j) * 65 + ch] = xc; XCb[(8 * g + j) * 72 + ch] = (bf16)f2bf(xc); }
#pragma unroll
    for (int r = 0; r < 3; ++r) A.out[O_SLCONV + (((size_t)l * 128 + bs) * 3 + r) * 256 + cg] = xn[8 + r];
    __syncthreads();
    { const int it = wave & 3, i = 16 * it + (lane & 15);
#pragma unroll
      for (int s = 0; s < 2; ++s) { const int et = (wave >> 2) * 2 + s, e0 = 16 * et + 4 * (lane >> 4);
        f32x4 ar = (f32x4){0.f, 0.f, 0.f, 0.f}, ai = ar;
        ar = mma_lds<64>(Wr + et * 16 * 72, 72, XCb + it * 16 * 72, 72, ar, lane);
        ai = mma_lds<64>(Wi + et * 16 * 72, 72, XCb + it * 16 * 72, 72, ai, lane);
        const f32x4 br = *(const f32x4*)(A.in[16] + l * 256 + blk * 64 + e0), bi = *(const f32x4*)(A.in[18] + l * 256 + blk * 64 + e0), lam = *(const f32x4*)(A.in[19] + l * 256 + blk * 64 + e0);
#pragma unroll
        for (int e = 0; e < 4; ++e) { const float r = sigm(ar[e] + br[e]), ig = sigm(ai[e] + bi[e]); const float la = -8.0f * r * log1pf(expf(-lam[e]));
            AA[i * 65 + e0 + e] = expf(la); BX[i * 65 + e0 + e] = sqrtf(-expm1f(2.0f * la)) * ig * XC[i * 65 + e0 + e]; } } }
    __syncthreads();
    { float h = A.in[5][((size_t)l * 128 + bs) * 256 + cg];
#pragma unroll
      for (int j = 0; j < 8; ++j) { const int i = 8 * g + j; h = AA[i * 65 + ch] * h + BX[i * 65 + ch]; HEADS[(row0 + i) * D + 384 + cg] = (bf16)f2bf(h * gelu_t(gbv[j])); }
      A.out[O_SLRU + ((size_t)l * 128 + bs) * 256 + cg] = h; }
    __syncthreads();
}

#define XB_TMO      128
#define XB_XCNT(j)  (256  + 64 * (j))
#define XB_XSUB(j)  (1280 + 64 * (j))
#define XB_XGEN(j)  (2304 + 64 * (j))
#define XB_TOP      3328
#define XB_TOPGEN   3392
#define XCD_BAR_WORDS 3456
#define XB_SPIN_CAP (1u << 18)

__device__ __forceinline__ unsigned xb_ld(unsigned* p)              { return __hip_atomic_load(p, __ATOMIC_RELAXED, __HIP_MEMORY_SCOPE_AGENT); }
__device__ __forceinline__ unsigned xb_add(unsigned* p, unsigned v) { return __hip_atomic_fetch_add(p, v, __ATOMIC_RELAXED, __HIP_MEMORY_SCOPE_AGENT); }
__device__ __forceinline__ unsigned xb_xcc_id() { return (unsigned)__builtin_amdgcn_s_getreg((3 << 11) | 20) & 0xFu; }
#define XB_SPIN(cond, bar) do { unsigned _sp = 0; while (cond) { __builtin_amdgcn_s_sleep(1); \
    if ((++_sp & 255u) == 0u) { if (xb_ld(&(bar)[XB_TMO])) break; if (_sp > XB_SPIN_CAP) { atomicAdd(&(bar)[XB_TMO], 1u); break; } } } } while (0)

struct XcdBarrier {
    unsigned* bar; unsigned x;
    volatile LAS unsigned* st;
};

__device__ __forceinline__ XcdBarrier xcd_barrier_post(unsigned* bar, volatile LAS unsigned* st, const bool leader) {
    XcdBarrier b; b.bar = bar; b.x = xb_xcc_id(); b.st = st;
    if (leader) (void)xb_add(&bar[XB_XCNT(b.x)], 1u);
    return b;
}
__device__ __forceinline__ void xcd_barrier_complete(unsigned* bar, unsigned x, unsigned& nloc, unsigned& nx) {
    const unsigned G = gridDim.x * gridDim.y * gridDim.z;
    unsigned sum, cnt, mine, sp = 0u;
    for (;;) {
        sum = 0u; cnt = 0u; mine = 0u;
#pragma unroll
        for (unsigned j = 0; j < 16; ++j) { const unsigned c = xb_ld(&bar[XB_XCNT(j)]); sum += c; cnt += (c > 0u) ? 1u : 0u; mine = (j == x) ? c : mine; }
        if (sum == G) break;
        __builtin_amdgcn_s_sleep(1);
        if ((++sp & 255u) == 0u) { if (xb_ld(&bar[XB_TMO])) break; if (sp > XB_SPIN_CAP) { atomicAdd(&bar[XB_TMO], 1u); break; } }
    }
    nloc = mine > 0u ? mine : 1u; nx = cnt > 0u ? cnt : 1u;
}

__device__ __forceinline__ void xcd_barrier(const XcdBarrier& b, const bool leader) {
    asm volatile("s_waitcnt vmcnt(0)" ::: "memory");
    __syncthreads();
    if (leader) {
        unsigned* bar = b.bar;
        __builtin_amdgcn_s_waitcnt(0);
        unsigned nloc = b.st[0], nx = b.st[1];
        if (nloc == 0u) { xcd_barrier_complete(bar, b.x, nloc, nx); b.st[0] = nloc; b.st[1] = nx; }
        const unsigned old = xb_add(&bar[XB_XSUB(b.x)], 1u);
        const unsigned gen = old / nloc;
        if (old + 1u == (gen + 1u) * nloc) {
            __builtin_amdgcn_fence(__ATOMIC_RELEASE, "agent");
            asm volatile("s_waitcnt vmcnt(0)" ::: "memory");
            const unsigned og = xb_add(&bar[XB_TOP], 1u);
            const unsigned tg = og / nx;
            if (og + 1u == (tg + 1u) * nx) xb_add(&bar[XB_TOPGEN], 1u);
            else XB_SPIN(xb_ld(&bar[XB_TOPGEN]) == tg, bar);
            __builtin_amdgcn_fence(__ATOMIC_ACQUIRE, "agent");
            xb_add(&bar[XB_XGEN(b.x)], 1u);
            asm volatile("s_waitcnt vmcnt(0)" ::: "memory");
        } else {
            XB_SPIN(xb_ld(&bar[XB_XGEN(b.x)]) == gen, bar);
            __builtin_amdgcn_fence(__ATOMIC_ACQUIRE, "agent");
            asm volatile("s_waitcnt vmcnt(0)" ::: "memory");
        }
    }
    __syncthreads();
}

#define FRESHA() CA* Aq = Ap; asm volatile("" : "+s"(Aq)); CA& A = *Aq;
#define FRESH() int tid = wave * 64 + fresh_lane(); asm volatile("" : "+v"(tid)); const int lane = tid & 63; (void)lane; LAS unsigned char* lds = lds0; asm volatile("" : "+v"(lds)); (void)lds; FRESHA();
#ifndef PH
#define PH 0xffff
#endif
#ifndef REP_M1
#define REP_M1 1
#endif
#ifndef REP_M2
#define REP_M2 1
#endif
#ifndef REP_G1
#define REP_G1 1
#endif
#ifndef REP_G3
#define REP_G3 1
#endif
#define GSYNC() do { XcdBarrier xb_; xb_.bar = (unsigned*)Ap->ws + 4096; xb_.x = xb_xcc_id(); const unsigned ln_ = (unsigned)fresh_lane(); LAS unsigned char* lb_ = lds0; asm volatile("" : "+v"(lb_)); xb_.st = (volatile LAS unsigned*)(lb_ + 147392); xcd_barrier(xb_, wave == 0 && ln_ == 0u); } while (0)
template <int l> __device__ __forceinline__ void layer_body(CA* Ap, LAS unsigned char* lds0, const int wave, const int bid, const int G, const int gw, const int NGW) {
        for (int rep = 0; rep < REP_G1; ++rep) if (PH & 1) { FRESHA(); pg8::Gemm g{(const bf16*)(A.ws + WS_XN), (const bf16*)(A.ws + WS_WIN), M, NPROJ, D}; pg8::StaticOrder S; S.init(M, NPROJ, G, bid);
          pg8::EpiProj E{(bf16*)(A.ws + WS_PROJ), NPROJ};
          pg8::gemm_phase<pg8::EpiProj, pg8::StaticOrder, true, true>(lds0, g, S, E, wave); }
        GSYNC();
        for (int rep = 0; rep < REP_M1; ++rep) {
            for (int u = bid; u < 768 + 768; u += G) { FRESH(); if (u < 768) { if (PH & 8) m1_delta_pair(A, lds, l, u, tid, lane, wave); } else { if (PH & 16) m1_gla_pair(A, lds, l, u - 768, tid, lane, wave); } }
        }
        GSYNC();
        {
            for (int rep = 0; rep < REP_M2; ++rep) for (int u = bid; u < 128; u += G) { FRESH(); if (u < 48) { if (PH & 32) m2_delta(A, lds, l, u, tid, lane, wave); } else if (u < 96) { if ((PH & 64) && rep == 0) m2_gla(A, lds, l, u - 48, tid, lane, wave); } else { if (PH & 128) m2_lru(A, lds, l, u - 96, tid, lane, wave); } __syncthreads(); }
            if (PH & 2) for (int u = bid - 128; u >= 0 && u < 64; u += (G > 128 ? G - 128 : G)) { FRESH(); lru_sample_wg(A, lds, l, u, tid, lane, wave); }
            int li, ln; if (G > 128) { li = (bid - 128) * NWAVES + wave; ln = (G - 128) * NWAVES; } else { li = gw; ln = NGW; }
            if (li >= 0) {
                if (PH & 4) for (int it = li; it < 1536; it += ln) { FRESH(); if (it < 768) sample_delta_item(A, l, it, lane); else sample_gla_item(A, l, it - 768, lane); }
            }
        }
        GSYNC();
        if (PH & 256) { FRESHA(); float* XF = A.out; pg8::Gemm g{(const bf16*)(A.ws + WS_XN), (const bf16*)(A.ws + WS_WOUT), M, D, D}; pg8::TailOrder S; S.init(G, bid, D);
          pg8::EpiResidT<false, true> E{l == 0 ? A.in[0] : XF, XF, ALPHA, (float*)(A.ws + WS_PART), 4, nullptr, (pg8::bf16_t*)(A.ws + WS_YB1)};
          pg8::gemm_phase<pg8::EpiResidT<false, true>, pg8::TailOrder, true, true>(lds0, g, S, E, wave); }
        GSYNC();
        { FRESH(); ln_pass<4, true, true>(A, A.in[24] + l * D, A.in[25] + l * D, true, false, (const float*)(A.ws + WS_PART), (const bf16*)(A.ws + WS_YB1), gw, NGW, lane); }
        GSYNC();
        for (int rep = 0; rep < REP_G3; ++rep) if (PH & 512) { FRESHA(); bf16* HB = (bf16*)(A.ws + WS_H); pg8::Gemm g{(const bf16*)(A.ws + WS_XN), (const bf16*)(A.ws + WS_WUP), M, NUP, D}; pg8::StaticOrder S; S.init(M, NUP, G, bid);
          pg8::EpiFfn E{HB, (float*)(A.ws + WS_GH), (float*)(A.ws + WS_GF), A.in[27] + (size_t)l * 3 * DFF, A.in[28] + (size_t)l * DFF, A.in[7] + (size_t)l * 128 * 2 * DFF,
                        A.out + O_PFCONV + (size_t)l * 8 * 2 * DFF, A.out + O_SFCONV + (size_t)l * 128 * 2 * DFF};
          pg8::gemm_phase<pg8::EpiFfn, pg8::StaticOrder, true, true>(lds0, g, S, E, wave); }
        GSYNC();
        if (PH & 1024) { FRESH(); float* XF = A.out; bf16* HB = (bf16*)(A.ws + WS_H); pg8::Gemm g{HB, (const bf16*)(A.ws + WS_WDN), M, D, DFF}; pg8::TailOrder S; S.init(G, bid, DFF);
          { const float* GH = (const float*)(A.ws + WS_GH); const float* GF = (const float*)(A.ws + WS_GF);
            const float* cw = A.in[27] + (size_t)l * 3 * DFF; const float* cb = A.in[28] + (size_t)l * DFF;
            pg8::Unit u;
            for (int i = 0; S.next(i, u); ++i) { if (u.pm >= 64) continue;
                f32x4 w0[2], w1[2], w2[2], bb[2];
#pragma unroll
                for (int q = 0; q < 2; ++q) { const int c = 4 * (tid + 512 * q); if (c < DFF) { w0[q] = *(const f32x4*)(cw + c); w1[q] = *(const f32x4*)(cw + DFF + c); w2[q] = *(const f32x4*)(cw + 2 * DFF + c); bb[q] = *(const f32x4*)(cb + c); } }
#pragma unroll
                for (int sl = 0; sl < 4; ++sl) { const int sp = 4 * u.pm + sl; const bool first = (sp & 31) == 0;
                    f32x4 a00[2], a01[2], a10[2], a11[2], h0[2], h1[2];
#pragma unroll
                    for (int q = 0; q < 2; ++q) { const int c = 4 * (tid + 512 * q); if (c < DFF) {
                        a00[q] = *(const f32x4*)(GF + (((size_t)sp * 2 + 0) * 2 + 0) * DFF + c); a01[q] = *(const f32x4*)(GF + (((size_t)sp * 2 + 0) * 2 + 1) * DFF + c);
                        a10[q] = *(const f32x4*)(GF + (((size_t)sp * 2 + 1) * 2 + 0) * DFF + c); a11[q] = *(const f32x4*)(GF + (((size_t)sp * 2 + 1) * 2 + 1) * DFF + c);
                        if (!first) { h0[q] = *(const f32x4*)(GH + ((size_t)(sp - 1) * 2 + 0) * DFF + c); h1[q] = *(const f32x4*)(GH + ((size_t)(sp - 1) * 2 + 1) * DFF + c); }
                        else { h0[q] = (f32x4){0.f, 0.f, 0.f, 0.f}; h1[q] = h0[q]; } } }
#pragma unroll
                    for (int q = 0; q < 2; ++q) { const int c = 4 * (tid + 512 * q); if (c < DFF) {
                        const f32x4 x0 = h0[q] * w0[q] + h1[q] * w1[q] + a00[q] * w2[q] + bb[q], x1 = h1[q] * w0[q] + a00[q] * w1[q] + a10[q] * w2[q] + bb[q];
                        v2u o0, o1;
                        o0.x = pk2(pg8::gelu_tanh_f(x0[0]) * a01[q][0], pg8::gelu_tanh_f(x0[1]) * a01[q][1]); o0.y = pk2(pg8::gelu_tanh_f(x0[2]) * a01[q][2], pg8::gelu_tanh_f(x0[3]) * a01[q][3]);
                        o1.x = pk2(pg8::gelu_tanh_f(x1[0]) * a11[q][0], pg8::gelu_tanh_f(x1[1]) * a11[q][1]); o1.y = pk2(pg8::gelu_tanh_f(x1[2]) * a11[q][2], pg8::gelu_tanh_f(x1[3]) * a11[q][3]);
                        *(v2u*)(HB + (size_t)(64 * sp) * DFF + c) = o0; *(v2u*)(HB + (size_t)(64 * sp + 1) * DFF + c) = o1; } } } }
            __threadfence(); __syncthreads(); }
          pg8::EpiResidT<true, l == 0> E{XF, XF, ALPHA, (float*)(A.ws + WS_PART), 11, (const pg8::bf16_t*)(A.ws + WS_XN), (pg8::bf16_t*)(A.ws + WS_YB2)};
          pg8::gemm_phase<pg8::EpiResidT<true, l == 0>, pg8::TailOrder, true, true>(lds0, g, S, E, wave); }
        GSYNC();
        { FRESH(); ln_pass<11, l == 0, l == 0>(A, A.in[30] + l * D, A.in[31] + l * D, l == 0, true, (const float*)(A.ws + WS_PART), (const bf16*)(A.ws + WS_YB2), gw, NGW, lane); }
        if (l == 0) { FRESH(); convert_weights(A, lds, 1, 0, CONV_ALL, gw, NGW, wave, lane); }
        if (l == 0) GSYNC();
}

__global__ void __launch_bounds__(NTHR, 2) hybrid_fwd(Args Akern) {
    extern __shared__ __attribute__((aligned(16))) unsigned char lds_raw[];
    cg::grid_group grid = cg::this_grid();
    LAS unsigned char* lds0 = (LAS unsigned char*)lds_raw;
    const int tid0 = threadIdx.x, wave = __builtin_amdgcn_readfirstlane(tid0 >> 6), bid = blockIdx.x, G = gridDim.x;
    const int gw = bid * NWAVES + wave, NGW = G * NWAVES;
    CA* Ap = (CA*)__builtin_amdgcn_kernarg_segment_ptr();

    unsigned* barw = (unsigned*)Akern.ws + 4096;
    volatile LAS unsigned* bst = (volatile LAS unsigned*)(lds0 + 147392);
    if (tid0 < 2) bst[tid0] = 0u;
    (void)xcd_barrier_post(barw, bst, tid0 == 0);
    if (Akern.ws == nullptr) grid.sync();
    { FRESH(); convert_weights(A, lds, 0, 0, CONV_ALL, gw, NGW, wave, lane); }
    { FRESH(); x_to_bf16(A, gw, NGW, lane); }
    GSYNC();

    layer_body<0>(Ap, lds0, wave, bid, G, gw, NGW);
    layer_body<1>(Ap, lds0, wave, bid, G, gw, NGW);
}

extern "C" void kernel_launch(void* const* d_in, const int* in_sizes, int n_in, void* d_out, int out_size, void* d_ws, size_t ws_size, hipStream_t stream) {
    static int grid = 0;
    if (grid == 0) {
        int dev = 0, cus = 0, per_cu = 0;
        if (n_in != 32 || (size_t)out_size != O_END || ws_size < 256 * MiB) { fprintf(stderr, "kernel_launch: unexpected shapes n_in %d out %d ws %zu\n", n_in, out_size, ws_size); grid = -1; return; }
        (void)hipGetDevice(&dev); (void)hipDeviceGetAttribute(&cus, hipDeviceAttributeMultiprocessorCount, dev);
        (void)hipFuncSetAttribute((const void*)hybrid_fwd, hipFuncAttributeMaxDynamicSharedMemorySize, LDS_BYTES);
        (void)hipOccupancyMaxActiveBlocksPerMultiprocessor(&per_cu, (const void*)hybrid_fwd, NTHR, LDS_BYTES);
        (void)hipGetLastError();
        if (per_cu < 1) per_cu = 1;
        grid = cus;
    }
    if (grid < 0) return;
    if (hipMemsetAsync(d_ws, 0, 65536, stream) != hipSuccess) { fprintf(stderr, "kernel_launch: hipMemsetAsync of the control words failed\n"); return; }
    Args a{};
    for (int i = 0; i < 32; ++i) a.in[i] = (const float*)d_in[i];
    a.out = (float*)d_out; a.ws = (unsigned char*)d_ws;
    void* args[] = {&a};
    hipError_t e = hipLaunchCooperativeKernel((const void*)hybrid_fwd, dim3(grid), dim3(NTHR), args, LDS_BYTES, stream);
    if (e != hipSuccess) fprintf(stderr, "cooperative launch failed: %s (grid %d)\n", hipGetErrorString(e), grid);
}
```

```cpp
#include <hip/hip_runtime.h>
#include <hip/hip_cooperative_groups.h>
#include <cstdio>
#include <cstdint>
namespace cg = cooperative_groups;
__device__ __forceinline__ int fresh_lane() { int x; asm volatile("v_mbcnt_lo_u32_b32 %0, -1, 0\n\tv_mbcnt_hi_u32_b32 %0, -1, %0" : "=v"(x)); return x; }
namespace pg8 {
#define PG8_LAS __attribute__((address_space(3)))
typedef unsigned short bf16_t;
typedef short bf16x8 __attribute__((ext_vector_type(8)));
typedef float f32x4 __attribute__((ext_vector_type(4)));
typedef unsigned u32x4 __attribute__((ext_vector_type(4)));
constexpr int BM = 256, BK = 64, HALF = 128, HTB = HALF * BK * 2  , STAGE_BYTES = 8 * HTB, NXCD = 8, WGM = 8;

__host__ __device__ __forceinline__ int lds_byte(int r, int c) { const int st = (r >> 4) * 2 + (c >> 5), rr = r & 15, cc = c & 31, ob = rr * 64 + cc * 2; return st * 1024 + (ob ^ (((ob >> 9) & 1) << 5)); }
__host__ __device__ __forceinline__ void stage_rc(int b, int& R, int& C) { const int st = b / 1024, sb = b % 1024, swz = sb ^ (((sb >> 9) & 1) << 5); R = (st >> 1) * 16 + swz / 64; C = (st & 1) * 32 + (swz % 64) / 2; }
__host__ __device__ __forceinline__ int perm32(int rho) { const int n = rho >> 4, i = rho & 15; return 8 * (i >> 2) + 4 * n + (i & 3); }

struct Unit { int pm, pn, k0, nt; };
struct Gemm { const bf16_t* A; const bf16_t* Bt; int M, N, K; };

struct StaticOrder {
    int nM, nN, nwg, G, c, knt;
    __host__ __device__ __forceinline__ void init(int M, int N, int G_, int c_, int K_ = 1024) { nM = M / BM; nN = N / BM; nwg = nM * nN; G = G_; c = c_; knt = K_ / BK; }
    __host__ __device__ __forceinline__ bool next(int i, Unit& u) const {
        const long L = (long)i * G + c; if (L >= nwg) return false;
        int wgid = (int)L; { const int q = nwg / NXCD, r = nwg % NXCD, xcd = wgid % NXCD, off = wgid / NXCD; wgid = (xcd < r ? xcd * (q + 1) : r * (q + 1) + (xcd - r) * q) + off; }
        const int nig = WGM * nN, gid = wgid / nig, fm = gid * WGM, gsz = (nM - fm) < WGM ? (nM - fm) : WGM;
        const int rem = wgid % nig; u.pm = fm + (rem & (gsz - 1)); u.pn = rem >> (31 - __builtin_clz(gsz)); u.k0 = 0; u.nt = knt; return true;
    }
    __device__ __forceinline__ void a_ready(const Unit&) const {}
    __device__ __forceinline__ void done(const Unit&) const {}
};

__device__ __forceinline__ unsigned cvt_pk_bf16(float lo, float hi) { unsigned r; asm volatile("v_cvt_pk_bf16_f32 %0, %1, %2" : "=v"(r) : "v"(lo), "v"(hi)); return r; }
struct TailOrder {
    StaticOrder so; int nsplit, G, c;
    __host__ __device__ __forceinline__ void init(int G_, int c_, int K_) { so.init(16384, 1024, G_, c_, K_); nsplit = K_ / 256; G = G_; c = c_; }
    __host__ __device__ __forceinline__ bool next(int i, Unit& u) const {
        const long L = (long)i * G + c;
        if (L < 256) return so.next(i, u);
        const int j = (int)L - 256; if (j >= 16 * nsplit) return false;
        const int ks = j % nsplit, uu = j / nsplit; u.pm = 64 + (uu >> 2); u.pn = uu & 3; u.k0 = ks * 256; u.nt = 4; return true;
    }
    __device__ __forceinline__ void a_ready(const Unit&) const {}
    __device__ __forceinline__ void done(const Unit&) const {}
};

typedef unsigned u32x2 __attribute__((ext_vector_type(2)));
__device__ __forceinline__ float gelu_tanh_f(float x) { const float t = 1.5957691216057308f * (x + 0.044715f * x * x * x); return x * __builtin_amdgcn_rcpf(1.0f + __expf(-t)); }

struct EpiProj {
    static constexpr bool PERM = true, AFTER_DRAIN = false;
    bf16_t* O; int ldc;
    __device__ __forceinline__ void operator()(const f32x4 (&acc)[2][2][4][2], const Unit& u, int wr, int wc, int fr, int fq) const {
        const int row0 = u.pm * BM + wr * 64 + fr, col0 = u.pn * BM + wc * 32 + 8 * fq;
#pragma unroll
        for (int ai = 0; ai < 2; ++ai)
#pragma unroll
            for (int m = 0; m < 4; ++m) { bf16_t* rowp = O + (size_t)(row0 + ai * HALF + m * 16) * ldc + col0;
#pragma unroll
                for (int bj = 0; bj < 2; ++bj) { const f32x4 v0 = acc[ai][bj][m][0], v1 = acc[ai][bj][m][1];
                    u32x4 w; w.x = cvt_pk_bf16(v0[0], v0[1]); w.y = cvt_pk_bf16(v0[2], v0[3]); w.z = cvt_pk_bf16(v1[0], v1[1]); w.w = cvt_pk_bf16(v1[2], v1[3]);
                    *(u32x4*)(rowp + bj * HALF) = w; } }
    }
};
template <bool RESB, bool OUTB> struct EpiResidT {
    static constexpr bool PERM = false, AFTER_DRAIN = false;
    const float* resP; float* out; float alpha; float* part; int nsplit; const bf16_t* resB; bf16_t* outB;
    __device__ __forceinline__ void operator()(const f32x4 (&acc)[2][2][4][2], const Unit& u, int wr, int wc, int fr, int fq) const {
        const int col0 = u.pn * BM + wc * 32 + 4 * fq;
        if (u.pm >= 64) {
            float* pt = part + (size_t)((((u.pm - 64) * 4 + u.pn) * nsplit) + (u.k0 >> 8)) * 65536;
#pragma unroll
            for (int ai = 0; ai < 2; ++ai)
#pragma unroll
                for (int m = 0; m < 4; ++m) { const unsigned ro = (unsigned)(ai * HALF + wr * 64 + m * 16 + fr) * 256u + (unsigned)(wc * 32 + 4 * fq);
#pragma unroll
                    for (int bj = 0; bj < 2; ++bj)
#pragma unroll
                        for (int n = 0; n < 2; ++n) *(f32x4*)(pt + (ro + (unsigned)(bj * HALF + n * 16))) = acc[ai][bj][m][n]; }
            return;
        }
#pragma unroll
        for (int ai = 0; ai < 2; ++ai)
#pragma unroll
            for (int m = 0; m < 4; ++m) { const unsigned ro = (unsigned)(u.pm * BM + ai * HALF + wr * 64 + m * 16 + fr) * 1024u + (unsigned)col0;
#pragma unroll
                for (int bj = 0; bj < 2; ++bj)
#pragma unroll
                    for (int n = 0; n < 2; ++n) { const unsigned o = ro + (unsigned)(bj * HALF + n * 16); f32x4 x; if constexpr (RESB) { const u32x2 rw = *(const u32x2*)(resB + o); x = (f32x4){__uint_as_float(rw.x << 16), __uint_as_float(rw.x & 0xffff0000u), __uint_as_float(rw.y << 16), __uint_as_float(rw.y & 0xffff0000u)}; } else x = *(const f32x4*)(resP + o);
                        const f32x4 y = x * alpha + acc[ai][bj][m][n];
                        if constexpr (OUTB) { u32x2 w; w.x = cvt_pk_bf16(y[0], y[1]); w.y = cvt_pk_bf16(y[2], y[3]); *(u32x2*)(outB + o) = w; } else *(f32x4*)(out + o) = y; } }
    }
};
struct EpiFfn {
    static constexpr bool PERM = true, AFTER_DRAIN = false;
    bf16_t* H; float* GH; float* GF; const float* cw; const float* cb; const float* st; float* pf; float* sf;
    __device__ __forceinline__ void operator()(const f32x4 (&acc)[2][2][4][2], const Unit& u, int wr, int wc, int fr, int fq) const {
        const int lane = fresh_lane();
#pragma unroll
        for (int n = 0; n < 2; ++n) {
            const int col = u.pn * 128 + wc * 32 + 8 * fq + 4 * n;
            const f32x4 w0 = *(const f32x4*)(cw + col), w1 = *(const f32x4*)(cw + 2816 + col), w2 = *(const f32x4*)(cw + 5632 + col), bb = *(const f32x4*)(cb + col);
#pragma unroll
            for (int ai = 0; ai < 2; ++ai) {
                const int rbase = u.pm * BM + ai * HALF + wr * 64; const bool sample = rbase >= 16384; const int span = rbase >> 6;
                f32x4 prev = (f32x4){0.f, 0.f, 0.f, 0.f};
#pragma unroll
                for (int m = 0; m < 4; ++m) {
                    const int row = rbase + 16 * m + fr;
                    const f32x4 cur = acc[ai][0][m][n], val = acc[ai][1][m][n];
                    f32x4 g1, g2;
#pragma unroll
                    for (int e = 0; e < 4; ++e) {
                        const int pr1 = __builtin_amdgcn_update_dpp(0, __float_as_int(prev[e]), 0x121, 0xf, 0xf, false), pr2 = __builtin_amdgcn_update_dpp(0, __float_as_int(prev[e]), 0x122, 0xf, 0xf, false);
                        g1[e] = __int_as_float(__builtin_amdgcn_update_dpp(pr1, __float_as_int(cur[e]), 0x111, 0xf, 0xf, false));
                        g2[e] = __int_as_float(__builtin_amdgcn_update_dpp(pr2, __float_as_int(cur[e]), 0x112, 0xf, 0xf, false)); }
                    bool skip = false;
                    if (sample) {
                        const int t = row & 7, bidx = (row - 16384) >> 3;
                        if (t < 2) { const f32x4 sa = *(const f32x4*)(st + ((size_t)bidx * 2 + 0) * 2816 + col), sb = *(const f32x4*)(st + ((size_t)bidx * 2 + 1) * 2816 + col);
                            if (t == 0) { g1 = sb; g2 = sa; } else { g2 = sb; } }
                        if (t >= 6) *(f32x4*)(sf + ((size_t)bidx * 2 + (t - 6)) * 2816 + col) = cur;
                    } else {
                        if (m == 0 && fr < 2) { skip = true; *(f32x4*)(GF + (((size_t)span * 2 + fr) * 2 + 0) * 2816 + col) = cur; *(f32x4*)(GF + (((size_t)span * 2 + fr) * 2 + 1) * 2816 + col) = val; }
                        if (m == 3 && fr >= 14) { *(f32x4*)(GH + ((size_t)span * 2 + (fr - 14)) * 2816 + col) = cur;
                            if ((row & 2047) >= 2046) *(f32x4*)(pf + ((size_t)(row >> 11) * 2 + (fr - 14)) * 2816 + col) = cur; }
                    }
                    if (!skip) { u32x2 w;
                        const f32x4 x = g2 * w0 + g1 * w1 + cur * w2 + bb;
                        const f32x4 t = x * (x * x * (-0.044715f * 1.5957691216057308f) + (-1.5957691216057308f));
                        f32x4 r; r[0] = __builtin_amdgcn_rcpf(1.0f + __expf(t[0])); r[1] = __builtin_amdgcn_rcpf(1.0f + __expf(t[1])); r[2] = __builtin_amdgcn_rcpf(1.0f + __expf(t[2])); r[3] = __builtin_amdgcn_rcpf(1.0f + __expf(t[3]));
                        const f32x4 hv = x * r * val;
                        w.x = cvt_pk_bf16(hv[0], hv[1]); w.y = cvt_pk_bf16(hv[2], hv[3]); *(u32x2*)(H + (size_t)row * 2816 + col) = w; }
                    prev = cur;
                }
            }
        }
    }
};
template <class Epi, class Sched, bool ALIGN_EPI = false, bool SP2 = false>
__device__ __forceinline__ void gemm_phase(PG8_LAS unsigned char* lds, const Gemm g, const Sched& S, const Epi& E, const int wave_in) {
    int tid = wave_in * 64 + fresh_lane(); asm volatile("" : "+v"(tid));
    const int wid = wave_in, lane = tid & 63, wr = wid >> 2, wc = wid & 3, fr = lane & 15, fq = lane >> 4;
    const int K = g.K;
    unsigned voffA[2], voffB[2];
#pragma unroll
    for (int i = 0; i < 2; ++i) { int R, C; stage_rc(tid * 16 + i * 8192, R, C); const int Rb = Epi::PERM ? ((R & ~31) + perm32(R & 31)) : R;
        voffA[i] = (unsigned)(R * K + C) * 2u; voffB[i] = (unsigned)(Rb * K + C) * 2u; }
    const size_t kstep = (size_t)(BK * 2);
    const size_t hstep = (size_t)HALF * K * 2;
    const size_t tstep = 2 * hstep;
    const unsigned ldsw = (unsigned)wid * 1024u;
    const int aoff = lds_byte(wr * 64 + fr, fq * 8), boff = lds_byte(wc * 32 + fr, fq * 8);
#define PG8_SA(b, h) (((b) * 2 + (h)) * HTB)
#define PG8_SB(b, h) ((4 + (b) * 2 + (h)) * HTB)
#define PG8_STAGE(bufoff, gbase, voff) do { _Pragma("unroll") for (int _i = 0; _i < 2; ++_i) \
        __builtin_amdgcn_global_load_lds((const unsigned*)((const char*)(gbase) + (voff)[_i]), (PG8_LAS unsigned*)(lds + (bufoff) + ldsw + _i * 8192), 16, 0, 0); } while (0)
#define PG8_LDA(dst, b, h) do { _Pragma("unroll") for (int m = 0; m < 4; ++m) _Pragma("unroll") for (int k = 0; k < 2; ++k) dst[m][k] = *(const PG8_LAS bf16x8*)(lds + PG8_SA(b, h) + aoff + m * 2048 + k * 1024); } while (0)
#define PG8_LDB(dst, b, h) do { _Pragma("unroll") for (int n = 0; n < 2; ++n) _Pragma("unroll") for (int k = 0; k < 2; ++k) dst[n][k] = *(const PG8_LAS bf16x8*)(lds + PG8_SB(b, h) + boff + n * 2048 + k * 1024); } while (0)
#define PG8_MMA(ai, bj, At, Bt) do { __builtin_amdgcn_s_setprio(1); _Pragma("unroll") for (int m = 0; m < 4; ++m) _Pragma("unroll") for (int n = 0; n < 2; ++n) _Pragma("unroll") for (int k = 0; k < 2; ++k) \
        acc[ai][bj][m][n] = __builtin_amdgcn_mfma_f32_16x16x32_bf16(Bt[n][k], At[m][k], acc[ai][bj][m][n], 0, 0, 0); __builtin_amdgcn_s_setprio(0); } while (0)
#define PG8_WAIT_V(n) asm volatile("s_waitcnt vmcnt(" #n ")" ::: "memory")
#define PG8_WAIT_L(n) asm volatile("s_waitcnt lgkmcnt(" #n ")" ::: "memory")
#define PG8_BAR __builtin_amdgcn_s_barrier()
#define PG8_SCHED __builtin_amdgcn_sched_barrier(0)
    Unit cur, nxt; int ui = 0;
    if (!S.next(0, cur)) return;
    f32x4 acc[2][2][4][2];
#pragma unroll
    for (int a = 0; a < 2; ++a)
#pragma unroll
        for (int b = 0; b < 2; ++b)
#pragma unroll
            for (int m = 0; m < 4; ++m)
#pragma unroll
                for (int n = 0; n < 2; ++n) acc[a][b][m][n] = (f32x4){0.f, 0.f, 0.f, 0.f};
    bf16x8 At[4][2], B0[2][2], B1[2][2];
    const char* cA = (const char*)g.A + (size_t)cur.pm * tstep + (size_t)cur.k0 * 2; const char* cB = (const char*)g.Bt + (size_t)cur.pn * tstep + (size_t)cur.k0 * 2;
    S.a_ready(cur);
    if constexpr (SP2) {
        PG8_STAGE(PG8_SB(0, 0), cB, voffB); PG8_STAGE(PG8_SB(0, 1), cB + hstep, voffB); PG8_STAGE(PG8_SA(0, 0), cA, voffA); PG8_STAGE(PG8_SA(0, 1), cA + hstep, voffA);
        if (wr == 1) PG8_BAR;
        PG8_WAIT_V(2); PG8_BAR;
        PG8_STAGE(PG8_SB(1, 0), cB + kstep, voffB); PG8_STAGE(PG8_SA(1, 0), cA + kstep, voffA); PG8_STAGE(PG8_SB(1, 1), cB + hstep + kstep, voffB);
        PG8_WAIT_V(6); PG8_BAR;
    } else {
        PG8_STAGE(PG8_SB(0, 0), cB, voffB); PG8_STAGE(PG8_SA(0, 0), cA, voffA); PG8_STAGE(PG8_SB(0, 1), cB + hstep, voffB); PG8_STAGE(PG8_SA(0, 1), cA + hstep, voffA);
        if (wr == 1) PG8_BAR;
        PG8_WAIT_V(4); PG8_BAR;
        PG8_STAGE(PG8_SB(1, 0), cB + kstep, voffB); PG8_STAGE(PG8_SA(1, 0), cA + kstep, voffA); PG8_STAGE(PG8_SB(1, 1), cB + hstep + kstep, voffB);
        PG8_WAIT_V(6); PG8_BAR;
    }
    for (;;) {
        const bool has_next = S.next(ui + 1, nxt);
        const char* nA = has_next ? (const char*)g.A + (size_t)nxt.pm * tstep + (size_t)nxt.k0 * 2 : cA; const char* nB = has_next ? (const char*)g.Bt + (size_t)nxt.pn * tstep + (size_t)nxt.k0 * 2 : cB;
        const int nt = cur.nt;
        for (int t = 0; t < nt; t += 2) {
            const bool last = (t == nt - 2);
            const char* a1 = cA + (size_t)(t + 1) * kstep;
            const char* a2 = last ? nA : cA + (size_t)(t + 2) * kstep; const char* b2 = last ? nB : cB + (size_t)(t + 2) * kstep;
            const char* a3 = a2 + kstep; const char* b3 = b2 + kstep;
            if (last && has_next) S.a_ready(nxt);
            if constexpr (SP2) {
            PG8_LDB(B0, 0, 0); PG8_LDB(B1, 0, 1); PG8_SCHED; PG8_LDA(At, 0, 0); PG8_STAGE(PG8_SA(1, 1), a1 + hstep, voffA);
            PG8_WAIT_V(8); PG8_WAIT_L(0); PG8_BAR; PG8_MMA(0, 0, At, B0); PG8_MMA(0, 1, At, B1); PG8_BAR; PG8_SCHED;
            PG8_LDA(At, 0, 1); PG8_STAGE(PG8_SB(0, 0), b2, voffB); PG8_STAGE(PG8_SB(0, 1), b2 + hstep, voffB); PG8_STAGE(PG8_SA(0, 0), a2, voffA);
            PG8_WAIT_V(8); PG8_WAIT_L(0); PG8_BAR; PG8_MMA(1, 0, At, B0); PG8_MMA(1, 1, At, B1); PG8_BAR; PG8_SCHED;
            PG8_LDB(B0, 1, 0); PG8_LDB(B1, 1, 1); PG8_SCHED; PG8_LDA(At, 1, 0); PG8_STAGE(PG8_SA(0, 1), a2 + hstep, voffA);
            PG8_WAIT_V(8); PG8_WAIT_L(0); PG8_BAR; PG8_MMA(0, 0, At, B0); PG8_MMA(0, 1, At, B1); PG8_BAR; PG8_SCHED;
            PG8_LDA(At, 1, 1); PG8_STAGE(PG8_SB(1, 0), b3, voffB); PG8_STAGE(PG8_SB(1, 1), b3 + hstep, voffB); PG8_STAGE(PG8_SA(1, 0), a3, voffA);
            PG8_WAIT_V(8); PG8_WAIT_L(0); PG8_BAR; PG8_MMA(1, 0, At, B0); PG8_MMA(1, 1, At, B1); PG8_BAR; PG8_SCHED;
            } else {
            PG8_LDB(B0, 0, 0); PG8_SCHED; PG8_LDA(At, 0, 0); PG8_STAGE(PG8_SA(1, 1), a1 + hstep, voffA);
            PG8_WAIT_L(8); PG8_BAR; PG8_WAIT_L(0); PG8_MMA(0, 0, At, B0); PG8_BAR; PG8_SCHED;
            PG8_LDB(B1, 0, 1); PG8_STAGE(PG8_SB(0, 0), b2, voffB);
            PG8_BAR; PG8_WAIT_L(0); PG8_MMA(0, 1, At, B1); PG8_BAR;
            PG8_LDA(At, 0, 1); PG8_STAGE(PG8_SA(0, 0), a2, voffA);
            PG8_BAR; PG8_WAIT_L(0); PG8_MMA(1, 0, At, B0); PG8_BAR; PG8_SCHED;
            PG8_STAGE(PG8_SB(0, 1), b2 + hstep, voffB);
            PG8_WAIT_V(6); PG8_BAR; PG8_MMA(1, 1, At, B1); PG8_BAR;
            PG8_LDB(B0, 1, 0); PG8_SCHED; PG8_LDA(At, 1, 0); PG8_STAGE(PG8_SA(0, 1), a2 + hstep, voffA);
            PG8_WAIT_L(8); PG8_BAR; PG8_WAIT_L(0); PG8_MMA(0, 0, At, B0); PG8_BAR; PG8_SCHED;
            PG8_LDB(B1, 1, 1); PG8_STAGE(PG8_SB(1, 0), b3, voffB);
            PG8_BAR; PG8_WAIT_L(0); PG8_MMA(0, 1, At, B1); PG8_BAR;
            PG8_LDA(At, 1, 1); PG8_STAGE(PG8_SA(1, 0), a3, voffA);
            PG8_BAR; PG8_WAIT_L(0); PG8_MMA(1, 0, At, B0); PG8_BAR; PG8_SCHED;
            PG8_STAGE(PG8_SB(1, 1), b3 + hstep, voffB);
            PG8_WAIT_V(6); PG8_BAR; PG8_MMA(1, 1, At, B1); PG8_BAR;
            }
        }
        if constexpr (ALIGN_EPI) { if (wr == 0) PG8_BAR; }
        if constexpr (!Epi::AFTER_DRAIN) { E(acc, cur, wr, wc, fr, fq); S.done(cur); }
        if (!has_next) break;
#pragma unroll
        for (int a = 0; a < 2; ++a)
#pragma unroll
            for (int b = 0; b < 2; ++b)
#pragma unroll
                for (int m = 0; m < 4; ++m)
#pragma unroll
                    for (int n = 0; n < 2; ++n) acc[a][b][m][n] = (f32x4){0.f, 0.f, 0.f, 0.f};
        cur = nxt; cA = nA; cB = nB; ++ui;
        if constexpr (ALIGN_EPI) { if (wr == 1) PG8_BAR; }
    }
    PG8_WAIT_V(0);
    if constexpr (!ALIGN_EPI) { if (wr == 0) PG8_BAR; }
    PG8_BAR;
    if constexpr (Epi::AFTER_DRAIN) { E.fused(acc, cur, wr, wc, fr, fq, lds, wid, lane); S.done(cur); }
#undef PG8_SA
#undef PG8_SB
#undef PG8_STAGE
#undef PG8_LDA
#undef PG8_LDB
#undef PG8_MMA
#undef PG8_WAIT_V
#undef PG8_WAIT_L
#undef PG8_BAR
#undef PG8_SCHED
}
}
#define LAS __attribute__((address_space(3)))
typedef unsigned short bf16;
typedef short bf16x8 __attribute__((ext_vector_type(8)));
typedef float f32x4 __attribute__((ext_vector_type(4)));
typedef unsigned v4u __attribute__((ext_vector_type(4)));
typedef unsigned v2u __attribute__((ext_vector_type(2)));
constexpr int NWAVES = 8, NTHR = 512;
constexpr int MP = 16384, MS = 1024, M = MP + MS, D = 1024, NPROJ = 3328, DFF = 2816, NUP = 5632, T = 2048;
constexpr int C_QA = 0, C_KA = 384, C_VA = 768, C_ZA = 1152, C_XB = 1536, C_GB = 1792, C_QC = 2048, C_KC = 2240, C_VC = 2432, C_ZC = 2816, C_LC = 3200, C_BA = 3216, C_AA = 3222;
constexpr float ALPHA = 1.4142135623730951f;
constexpr float EPS = 1e-6f;
constexpr size_t O_Y = 0, O_PDCONV = (size_t)M * D, O_PDELTA = O_PDCONV + 2 * 8 * 3 * 1152, O_PLCONV = O_PDELTA + 2 * 8 * 6 * 4096, O_PLRU = O_PLCONV + 2 * 8 * 3 * 256,
    O_PGLA = O_PLRU + 2 * 8 * 256, O_PFCONV = O_PGLA + 2 * 8 * 6 * 2048, O_SDCONV = O_PFCONV + 2 * 8 * 2 * 2816, O_SDELTA = O_SDCONV + 2 * 128 * 3 * 1152,
    O_SLCONV = O_SDELTA + (size_t)2 * 128 * 6 * 4096, O_SLRU = O_SLCONV + 2 * 128 * 3 * 256, O_SGLA = O_SLRU + 2 * 128 * 256, O_SFCONV = O_SGLA + (size_t)2 * 128 * 6 * 2048,
    O_END = O_SFCONV + (size_t)2 * 128 * 2 * 2816;
constexpr size_t MiB = 1u << 20;
constexpr size_t WS_WIN = 1 * MiB, WS_WOUT = WS_WIN + (size_t)NPROJ * D * 2, WS_WUP = WS_WOUT + (size_t)D * D * 2, WS_WDN = WS_WUP + (size_t)NUP * D * 2;
constexpr size_t WS_XN = 26 * MiB;
constexpr size_t WS_R = 60 * MiB;
constexpr size_t WS_PROJ = WS_R;
constexpr size_t WS_DT = 171 * MiB;
constexpr size_t WS_GQ = 231 * MiB, WS_GU = 237 * MiB, WS_GD = 249 * MiB, WS_AB = 250 * MiB, WS_GAM = 251 * MiB;
constexpr size_t WS_H = WS_R, WS_GH = 154 * MiB, WS_GF = 160 * MiB, WS_PART = 210 * MiB, WS_YB1 = WS_R, WS_YB2 = 172 * MiB;
static_assert(WS_WDN + (size_t)D * DFF * 2 <= WS_XN && WS_XN + (size_t)M * D * 2 <= WS_R && WS_PROJ + (size_t)M * NPROJ * 2 <= WS_DT && WS_H + (size_t)M * DFF * 2 <= WS_GH, "ws map");
constexpr int LDS_BYTES = 147456;

__device__ __forceinline__ float bf2f(bf16 v) { return __uint_as_float((unsigned)v << 16); }
__device__ __forceinline__ unsigned f2bf(float f) { unsigned u = __float_as_uint(f); return (u + 0x7fffu + ((u >> 16) & 1u)) >> 16; }
__device__ __forceinline__ unsigned pk2(float lo, float hi) { return f2bf(lo) | (f2bf(hi) << 16); }
__device__ __forceinline__ float shidx(float v, int src) { return __int_as_float(__builtin_amdgcn_ds_bpermute(src << 2, __float_as_int(v))); }
__device__ __forceinline__ float shx(float v, int o, int lane) { return shidx(v, lane ^ o); }
__device__ __forceinline__ float wave_sum(float v, int lane) {
#pragma unroll
    for (int o = 1; o < 64; o <<= 1) v += shx(v, o, lane);
    return v;
}
__device__ __forceinline__ float sigm(float x) { return __builtin_amdgcn_rcpf(1.0f + __expf(-x)); }
__device__ __forceinline__ float siluf(float x) { return x * __builtin_amdgcn_rcpf(1.0f + __expf(-x)); }
__device__ __forceinline__ float softplusf(float x) { return x > 20.f ? x : log1pf(expf(x)); }
__device__ __forceinline__ float gelu_t(float x) { const float t = 1.5957691216057308f * (x + 0.044715f * x * x * x); return x * __builtin_amdgcn_rcpf(1.0f + __expf(-t)); }
__device__ __forceinline__ float rdlane(float v, int l) { return __int_as_float(__builtin_amdgcn_readlane(__float_as_int(v), l)); }
#define LDS_WAIT() asm volatile("s_waitcnt lgkmcnt(0)" ::: "memory")

template <int K> __device__ __forceinline__ f32x4 mma_lds(const LAS bf16* X1, int ld1, const LAS bf16* X2, int ld2, f32x4 acc, int lane) {
    const int r = lane & 15, q8 = (lane >> 4) * 8;
#pragma unroll
    for (int k0 = 0; k0 < K; k0 += 32) {
        const bf16x8 a = *(const LAS bf16x8*)(X1 + r * ld1 + k0 + q8);
        const bf16x8 b = *(const LAS bf16x8*)(X2 + r * ld2 + k0 + q8);
        acc = __builtin_amdgcn_mfma_f32_16x16x32_bf16(a, b, acc, 0, 0, 0);
    }
    return acc;
}

struct Args { const float* in[32]; float* out; unsigned char* ws; };
typedef const __attribute__((address_space(4))) Args CA;

__device__ __forceinline__ void transpose_item(const float* W, int K, int Nsrc, int mode, bf16* WT, LAS float* scr, int item, int nblk, int lane) {
    const int kb = item / nblk, nb = item % nblk, k0 = 64 * kb, n0 = 32 * nb;
    const int n = n0 + (lane & 31); int sc;
    if (mode == 0) sc = n;
    else if (mode == 1) sc = n < 1536 ? n : (n < 3216 ? n + 12 : (n < 3228 ? n - 1680 : -1));
    else { const int j = n & 255, pn = n >> 8; sc = j < 128 ? pn * 128 + j : 2816 + pn * 128 + (j - 128); }
#pragma unroll 8
    for (int i = 0; i < 32; ++i) { const int kk = 2 * i + (lane >> 5); scr[kk * 33 + (lane & 31)] = sc >= 0 ? W[(size_t)(k0 + kk) * Nsrc + sc] : 0.f; }
    LDS_WAIT();
    const int c = lane & 7;
#pragma unroll
    for (int j = 0; j < 4; ++j) { const int nn = (lane >> 3) + 8 * j; const LAS float* s = scr + (8 * c) * 33 + nn;
        v4u o; o.x = pk2(s[0 * 33], s[1 * 33]); o.y = pk2(s[2 * 33], s[3 * 33]); o.z = pk2(s[4 * 33], s[5 * 33]); o.w = pk2(s[6 * 33], s[7 * 33]);
        *(v4u*)(WT + (size_t)(n0 + nn) * K + k0 + 8 * c) = o; }
    LDS_WAIT();
}
__device__ __forceinline__ void convert_item(CA& A, LAS float* scr, int l, int it, int lane) {
    constexpr int I1 = 16 * 104, I2 = 16 * 32, I3 = 16 * 176;
    int r = it;
    if (r < I1) { transpose_item(A.in[8] + (size_t)l * D * 3228, D, 3228, 1, (bf16*)(A.ws + WS_WIN), scr, r, 104, lane); return; } r -= I1;
    if (r < I2) { transpose_item(A.in[23] + (size_t)l * D * D, D, D, 0, (bf16*)(A.ws + WS_WOUT), scr, r, 32, lane); return; } r -= I2;
    if (r < I3) { transpose_item(A.in[26] + (size_t)l * D * NUP, D, NUP, 2, (bf16*)(A.ws + WS_WUP), scr, r, 176, lane); return; } r -= I3;
    transpose_item(A.in[29] + (size_t)l * DFF * D, DFF, D, 0, (bf16*)(A.ws + WS_WDN), scr, r, 32, lane);
}
constexpr int CONV_IN = 16 * 104, CONV_A = 16 * 104 + 16 * 32 + 16 * 176, CONV_ALL = CONV_A + 44 * 32;
__device__ __forceinline__ void convert_weights(CA& A, LAS unsigned char* lds, int l, int first, int last, int gw, int NGW, int wave, int lane) {
    LAS float* scr = (LAS float*)(lds + wave * 16384);
    for (int it = first + gw; it < last; it += NGW) convert_item(A, scr, l, it, lane);
}
__device__ __forceinline__ void convert_weights_queue(CA& A, LAS unsigned char* lds, int l, unsigned* ctr, int wave, int lane) {
    LAS float* scr = (LAS float*)(lds + wave * 16384);
    for (;;) {
        unsigned it = 0u; if (lane == 0) it = __hip_atomic_fetch_add(ctr, 1u, __ATOMIC_RELAXED, __HIP_MEMORY_SCOPE_AGENT);
        it = (unsigned)__builtin_amdgcn_readfirstlane((int)it);
        if (it >= (unsigned)CONV_A) break;
        convert_item(A, scr, l, (int)it, lane);
    }
}
__device__ __forceinline__ void x_to_bf16(CA& A, int gw, int NGW, int lane) {
    bf16* XN = (bf16*)(A.ws + WS_XN);
    for (int m = gw; m < M; m += NGW) {
        const float* xr = m < MP ? A.in[0] + (size_t)m * D : A.in[1] + (size_t)(m - MP) * D;
        const f32x4* x4 = (const f32x4*)xr + lane; v2u* o = (v2u*)(XN + (size_t)m * D) + lane;
#pragma unroll
        for (int j = 0; j < 4; ++j) { const f32x4 v = x4[64 * j]; v2u w; w.x = pk2(v[0], v[1]); w.y = pk2(v[2], v[3]); o[64 * j] = w;
            if (m >= MP) ((f32x4*)(A.out + (size_t)m * D) + lane)[64 * j] = v * ALPHA; }
    }
}
template <int nsplit, bool INB> __device__ __forceinline__ void ln_load(CA& A, const float* part, const bf16* yb, int m, int lane, f32x4 (&v)[4]) {
    const f32x4* x4 = (const f32x4*)(A.out + (size_t)m * D) + lane;
    if (INB && m < MP) { const v2u* y2 = (const v2u*)(yb + (size_t)m * D) + lane;
#pragma unroll
        for (int j = 0; j < 4; ++j) { const v2u w = y2[64 * j]; v[j] = (f32x4){__uint_as_float(w.x << 16), __uint_as_float(w.x & 0xffff0000u), __uint_as_float(w.y << 16), __uint_as_float(w.y & 0xffff0000u)}; }
    } else {
#pragma unroll
        for (int j = 0; j < 4; ++j) v[j] = x4[64 * j]; }
    if (m >= MP) { const int pmq = (m - MP) >> 8, r = (m - MP) & 255;
#pragma unroll
        for (int j = 0; j < 4; ++j) { const float* pp = part + (size_t)((pmq * 4 + j) * nsplit) * 65536 + (size_t)r * 256 + 4 * lane;
            f32x4 pv[nsplit];
#pragma unroll
            for (int ks = 0; ks < nsplit; ++ks) pv[ks] = *(const f32x4*)(pp + (size_t)ks * 65536);
#pragma unroll
            for (int ks = 0; ks < nsplit; ++ks) v[j] = v[j] + pv[ks]; } }
}
template <bool WXN> __device__ __forceinline__ void ln_finish(CA& A, const float* g, const float* b, bool prescale, bool f32_prompt, int m, int lane, f32x4 (&v)[4]) {
    f32x4* x4 = (f32x4*)(A.out + (size_t)m * D) + lane; v2u* o = (v2u*)((bf16*)(A.ws + WS_XN) + (size_t)m * D) + lane;
    float s = 0.f;
#pragma unroll
    for (int j = 0; j < 4; ++j) s += (v[j][0] + v[j][1]) + (v[j][2] + v[j][3]);
    const float mean = wave_sum(s, lane) * (1.f / D); float s2 = 0.f;
#pragma unroll
    for (int j = 0; j < 4; ++j) { v[j] = v[j] - mean; s2 += (v[j][0] * v[j][0] + v[j][1] * v[j][1]) + (v[j][2] * v[j][2] + v[j][3] * v[j][3]); }
    const float rstd = 1.0f / sqrtf(wave_sum(s2, lane) * (1.f / D) + EPS);
#pragma unroll
    for (int j = 0; j < 4; ++j) { const f32x4 gg = *((const f32x4*)g + lane + 64 * j), bb = *((const f32x4*)b + lane + 64 * j);
        const f32x4 y = v[j] * rstd * gg + bb; if (f32_prompt || m >= MP) x4[64 * j] = (prescale && m >= MP) ? y * ALPHA : y;
        if constexpr (WXN) { v2u w; w.x = pk2(y[0], y[1]); w.y = pk2(y[2], y[3]); o[64 * j] = w; } }
}
template <int nsplit, bool INB, bool WXN> __device__ __forceinline__ void ln_pass(CA& A, const float* g, const float* b, bool prescale, bool f32_prompt, const float* part, const bf16* yb, int gw, int NGW, int lane) {
    for (int m = gw; m < M; m += 2 * NGW) {
        const int m2 = m + NGW; const bool two = m2 < M;
        f32x4 va[4], vb[4];
        ln_load<nsplit, INB>(A, part, yb, m, lane, va);
        if (two) ln_load<nsplit, INB>(A, part, yb, m2, lane, vb);
        ln_finish<WXN>(A, g, b, prescale, f32_prompt, m, lane, va);
        if (two) ln_finish<WXN>(A, g, b, prescale, f32_prompt, m2, lane, vb);
    }
}

__device__ __forceinline__ void sample_delta_item(CA& A, int l, int item, int lane) {
    const int h = item % 6, b = item / 6;
    const bf16* PROJ = (const bf16*)(A.ws + WS_PROJ); bf16* HEADS = (bf16*)(A.ws + WS_XN);
    const size_t row0 = (size_t)MP + b * 8;
    float S[64];
    const float* S0 = A.in[3] + (((size_t)l * 128 + b) * 6 + h) * 4096 + lane;
#pragma unroll
    for (int k = 0; k < 64; ++k) S[k] = S0[k * 64];
    const float* cs = A.in[2] + ((size_t)l * 128 + b) * 3 * 1152; const float* cwp = A.in[9] + (size_t)l * 4 * 1152;
    const int cq = h * 64 + lane, ck = 384 + cq, cv = 768 + cq;
    const float wq0 = cwp[cq], wq1 = cwp[1152 + cq], wq2 = cwp[2304 + cq], wq3 = cwp[3456 + cq];
    const float wk0 = cwp[ck], wk1 = cwp[1152 + ck], wk2 = cwp[2304 + ck], wk3 = cwp[3456 + ck];
    const float wv0 = cwp[cv], wv1 = cwp[1152 + cv], wv2 = cwp[2304 + cv], wv3 = cwp[3456 + cv];
    float q0 = cs[cq], q1 = cs[1152 + cq], q2 = cs[2304 + cq], k0 = cs[ck], k1 = cs[1152 + ck], k2 = cs[2304 + ck], v0 = cs[cv], v1 = cs[1152 + cv], v2 = cs[2304 + cv];
    const float ae = expf(A.in[10][l * 6 + h]), dtb = A.in[11][l * 6 + h], nw = A.in[12][l * 64 + lane];
#pragma unroll 1
    for (int t = 0; t < 8; ++t) {
        const size_t row = row0 + t; const bf16* pr = PROJ + row * NPROJ;
        const float pq = bf2f(pr[cq]), pk = bf2f(pr[ck]), pv = bf2f(pr[cv]);
        const float qv = siluf(q0 * wq0 + q1 * wq1 + q2 * wq2 + pq * wq3), kv = siluf(k0 * wk0 + k1 * wk1 + k2 * wk2 + pk * wk3), vv = siluf(v0 * wv0 + v1 * wv1 + v2 * wv2 + pv * wv3);
        q0 = q1; q1 = q2; q2 = pq; k0 = k1; k1 = k2; k2 = pk; v0 = v1; v1 = v2; v2 = pv;
        const float rq = rsqrtf(wave_sum(qv * qv, lane) + EPS) * 0.125f, rk = rsqrtf(wave_sum(kv * kv, lane) + EPS);
        const float qn = qv * rq, kn = kv * rk;
        const float beta = sigm(bf2f(pr[C_BA + h]));
        const float a = expf(-ae * softplusf(bf2f(pr[C_AA + h]) + dtb));
        float kS = 0.f;
#pragma unroll
        for (int k = 0; k < 64; ++k) kS += rdlane(kn, k) * S[k];
        const float dv = beta * (vv - a * kS);
        float o = 0.f;
#pragma unroll
        for (int k = 0; k < 64; ++k) { S[k] = a * S[k] + rdlane(kn, k) * dv; o += rdlane(qn, k) * S[k]; }
        const float rinv = rsqrtf(wave_sum(o * o, lane) * (1.f / 64.f) + EPS);
        const float z = bf2f(pr[C_ZA + h * 64 + lane]);
        HEADS[row * D + h * 64 + lane] = (bf16)f2bf(o * rinv * nw * siluf(z));
    }
    float* dc = A.out + O_SDCONV + ((size_t)l * 128 + b) * 3 * 1152;
    dc[cq] = q0; dc[1152 + cq] = q1; dc[2304 + cq] = q2; dc[ck] = k0; dc[1152 + ck] = k1; dc[2304 + ck] = k2; dc[cv] = v0; dc[1152 + cv] = v1; dc[2304 + cv] = v2;
    int lane2 = lane; asm volatile("" : "+v"(lane2));
    float* So = A.out + O_SDELTA + (((size_t)l * 128 + b) * 6 + h) * 4096 + lane2;
#pragma unroll
    for (int k = 0; k < 64; ++k) So[k * 64] = S[k];
}
__device__ __forceinline__ void sample_gla_item(CA& A, int l, int item, int lane) {
    const int h = item % 6, b = item / 6;
    const bf16* PROJ = (const bf16*)(A.ws + WS_PROJ); bf16* HEADS = (bf16*)(A.ws + WS_XN);
    const size_t row0 = (size_t)MP + b * 8;
    float S[32];
    const float* S0 = A.in[6] + (((size_t)l * 128 + b) * 6 + h) * 2048 + lane;
#pragma unroll
    for (int k = 0; k < 32; ++k) S[k] = S0[k * 64];
    const int kl = lane & 31;
    float w2[16];
#pragma unroll
    for (int r = 0; r < 16; ++r) w2[r] = A.in[20][((size_t)l * 16 + r) * 192 + h * 32 + kl];
    const float b2 = A.in[21][l * 192 + h * 32 + kl], nw = A.in[22][l * 64 + lane];
#pragma unroll 1
    for (int t = 0; t < 8; ++t) {
        const size_t row = row0 + t;
        float lg = b2;
#pragma unroll
        for (int r = 0; r < 16; ++r) lg += bf2f(PROJ[row * NPROJ + C_LC + r]) * w2[r];
        const float f = expf(-softplusf(-lg) * (1.f / 16.f));
        const float qk_ = bf2f(PROJ[row * NPROJ + C_QC + h * 32 + kl]) * 0.17677669529663687f, kk_ = bf2f(PROJ[row * NPROJ + C_KC + h * 32 + kl]);
        const float v = bf2f(PROJ[row * NPROJ + C_VC + h * 64 + lane]);
        float o = 0.f;
#pragma unroll
        for (int k = 0; k < 32; ++k) { S[k] = rdlane(f, k) * S[k] + rdlane(kk_, k) * v; o += rdlane(qk_, k) * S[k]; }
        const float rinv = rsqrtf(wave_sum(o * o, lane) * (1.f / 64.f) + EPS);
        const float z = bf2f(PROJ[row * NPROJ + C_ZC + h * 64 + lane]);
        HEADS[row * D + 640 + h * 64 + lane] = (bf16)f2bf(o * rinv * nw * siluf(z));
    }
    int lane2 = lane; asm volatile("" : "+v"(lane2));
    float* So = A.out + O_SGLA + (((size_t)l * 128 + b) * 6 + h) * 2048 + lane2;
#pragma unroll
    for (int k = 0; k < 32; ++k) So[k * 64] = S[k];
}

__device__ __forceinline__ void m1_delta_pair(CA& A, LAS unsigned char* lds, int l, int u, int tid, int lane, int wave) {
    constexpr int SUBB = 69632;
    const int item0 = 2 * u, bh = item0 >> 5, c0 = item0 & 31, b = bh / 6, h = bh % 6;
    const bf16* PROJ = (const bf16*)(A.ws + WS_PROJ);
    bf16* DT = (bf16*)(A.ws + WS_DT); constexpr size_t TS = (size_t)1536 * 4096;
    const float* cwp = A.in[9] + (size_t)l * 4 * 1152;
#pragma unroll
    for (int sub = 0; sub < 2; ++sub) {
        LAS float* Qf = (LAS float*)(lds + sub * SUBB); LAS float* Kf = Qf + 64 * 65; LAS float* Vf = Kf + 64 * 65;
        const int c = c0 + sub; const long row0 = (long)b * T + c * 64;
        const int ch = tid & 63, g = tid >> 6;
#pragma unroll
        for (int ten = 0; ten < 3; ++ten) {
            const int col = ten * 384 + h * 64 + ch;
            const float w0 = cwp[col], w1 = cwp[1152 + col], w2 = cwp[2304 + col], w3 = cwp[3456 + col];
            float x[11];
#pragma unroll
            for (int r = 0; r < 11; ++r) { const int i = 8 * g - 3 + r; x[r] = (c * 64 + i >= 0) ? bf2f(PROJ[(size_t)(row0 + i) * NPROJ + col]) : 0.f; }
            LAS float* dst = ten == 0 ? Qf : (ten == 1 ? Kf : Vf);
#pragma unroll
            for (int j = 0; j < 8; ++j) dst[(8 * g + j) * 65 + ch] = siluf(x[j] * w0 + x[j + 1] * w1 + x[j + 2] * w2 + x[j + 3] * w3);
        }
    }
    if (tid < 128) {
        const int sub = tid >> 6, i = tid & 63; LAS float* Gs = (LAS float*)(lds + sub * SUBB + 68352); LAS float* BETA = Gs + 64;
        const size_t pr = (size_t)((long)b * T + (c0 + sub) * 64 + i) * NPROJ;
        BETA[i] = sigm(bf2f(PROJ[pr + C_BA + h])); Gs[i] = -expf(A.in[10][l * 6 + h]) * softplusf(bf2f(PROJ[pr + C_AA + h]) + A.in[11][l * 6 + h]); }
    __syncthreads();
    if (wave < 2) { LAS float* Gs = (LAS float*)(lds + wave * SUBB + 68352); LAS float* GC = Gs + 128; float s = Gs[lane];
#pragma unroll
        for (int o = 1; o < 64; o <<= 1) { const float t = shidx(s, (lane - o) & 63); if (lane >= o) s += t; }
        GC[lane] = s; }
#pragma unroll
    for (int sub = 0; sub < 2; ++sub) {
        LAS float* Qf = (LAS float*)(lds + sub * SUBB); LAS float* Kf = Qf + 64 * 65;
        LAS bf16* Kb = (LAS bf16*)(lds + sub * SUBB + 49920); LAS bf16* Qb = Kb + 64 * 72;
        LAS float* Gs = (LAS float*)(lds + sub * SUBB + 68352); LAS float* BETA = Gs + 64; LAS float* RQ = Gs + 192; LAS float* RK = Gs + 256;
        const long row0 = (long)b * T + (c0 + sub) * 64;
        const int i = tid >> 3, p = tid & 7; float q[8], k[8], sq = 0.f, sk = 0.f;
#pragma unroll
        for (int d = 0; d < 8; ++d) { q[d] = Qf[i * 65 + 8 * p + d]; k[d] = Kf[i * 65 + 8 * p + d]; sq += q[d] * q[d]; sk += k[d] * k[d]; }
        sq += shx(sq, 1, lane); sq += shx(sq, 2, lane); sq += shx(sq, 4, lane);
        sk += shx(sk, 1, lane); sk += shx(sk, 2, lane); sk += shx(sk, 4, lane);
        const float rq = rsqrtf(sq + EPS) * 0.125f, rk = rsqrtf(sk + EPS);
        v4u wq, wk; wq.x = pk2(q[0] * rq, q[1] * rq); wq.y = pk2(q[2] * rq, q[3] * rq); wq.z = pk2(q[4] * rq, q[5] * rq); wq.w = pk2(q[6] * rq, q[7] * rq);
        wk.x = pk2(k[0] * rk, k[1] * rk); wk.y = pk2(k[2] * rk, k[3] * rk); wk.z = pk2(k[4] * rk, k[5] * rk); wk.w = pk2(k[6] * rk, k[7] * rk);
        *(LAS v4u*)(Qb + i * 72 + 8 * p) = wq; *(LAS v4u*)(Kb + i * 72 + 8 * p) = wk;
        if (p == 0) { RQ[i] = rq; RK[i] = rk; }
    }
    __syncthreads();
    f32x4 Lt_[4];
#pragma unroll
    for (int s = 0; s < 8; ++s) {
        const int t = wave + 8 * s, sub = t >> 5, kind = (t >> 4) & 1, at = (t >> 2) & 3, bt = t & 3;
        LAS bf16* Kb = (LAS bf16*)(lds + sub * SUBB + 49920); LAS bf16* Qb = Kb + 64 * 72;
        LAS float* Gs = (LAS float*)(lds + sub * SUBB + 68352); LAS float* BETA = Gs + 64; LAS float* GC = Gs + 128;
        const int i = 16 * bt + (lane & 15), j0 = 16 * at + 4 * (lane >> 4);
        f32x4 acc = (f32x4){0.f, 0.f, 0.f, 0.f};
        if (at <= bt) acc = mma_lds<64>(Kb + at * 16 * 72, 72, (kind ? Qb : Kb) + bt * 16 * 72, 72, acc, lane);
        const float gi = GC[i];
        if (kind == 0) { const float bi = BETA[i]; f32x4 o;
#pragma unroll
            for (int e = 0; e < 4; ++e) { const int j = j0 + e; o[e] = (j < i) ? bi * acc[e] * __expf(gi - GC[j]) : 0.f; }
            Lt_[(s & 1) + 2 * (s >> 2)] = o;
        } else { float o[4];
#pragma unroll
            for (int e = 0; e < 4; ++e) { const int j = j0 + e; o[e] = (j <= i) ? acc[e] * __expf(gi - GC[j]) : 0.f; }
            v2u w; w.x = pk2(o[0], o[1]); w.y = pk2(o[2], o[3]); *(v2u*)(DT + 2 * TS + (size_t)(item0 + sub) * 4096 + i * 64 + j0) = w; }
    }
    __syncthreads();
#pragma unroll
    for (int s = 0; s < 8; ++s) {
        const int t = wave + 8 * s, sub = t >> 5, kind = (t >> 4) & 1, at = (t >> 2) & 3, bt = t & 3;
        if (kind == 0) { LAS float* Lm = (LAS float*)(lds + sub * SUBB + 49920); const int i = 16 * bt + (lane & 15), j0 = 16 * at + 4 * (lane >> 4);
            *(LAS f32x4*)(Lm + i * 68 + j0) = Lt_[(s & 1) + 2 * (s >> 2)]; }
    }
    __syncthreads();
    if (wave < 4) {
        const int sub = wave >> 1, cidx = tid & 127, item = item0 + sub;
        LAS float* Qf = (LAS float*)(lds + sub * SUBB); LAS float* Kf = Qf + 64 * 65; LAS float* Vf = Kf + 64 * 65;
        LAS float* Lm = (LAS float*)(lds + sub * SUBB + 49920);
        LAS float* Gs = (LAS float*)(lds + sub * SUBB + 68352); LAS float* BETA = Gs + 64; LAS float* GC = Gs + 128; LAS float* RK = Gs + 256;
        bf16* gWK = DT + (size_t)item * 4096; bf16* gUT = gWK + 4 * TS;
        float x[64];
        if (cidx < 64) {
#pragma unroll
            for (int i = 0; i < 64; ++i) x[i] = BETA[i] * Vf[i * 65 + cidx];
        } else { const int kc = cidx - 64;
#pragma unroll
            for (int i = 0; i < 64; ++i) x[i] = BETA[i] * __expf(GC[i]) * RK[i] * Kf[i * 65 + kc]; }
#pragma unroll
        for (int i = 1; i < 64; ++i) { float s0 = 0.f, s1 = 0.f, s2 = 0.f, s3 = 0.f;
#pragma unroll
            for (int j4 = 0; j4 < (i + 3) / 4; ++j4) { const f32x4 Lv = *(const LAS f32x4*)(Lm + i * 68 + 4 * j4);
                s0 += Lv[0] * x[4 * j4]; s1 += Lv[1] * x[4 * j4 + 1]; s2 += Lv[2] * x[4 * j4 + 2]; s3 += Lv[3] * x[4 * j4 + 3]; }
            x[i] -= (s0 + s1) + (s2 + s3); }
        if (cidx < 64) {
#pragma unroll
            for (int j8 = 0; j8 < 8; ++j8) { v4u w; w.x = pk2(x[8 * j8], x[8 * j8 + 1]); w.y = pk2(x[8 * j8 + 2], x[8 * j8 + 3]); w.z = pk2(x[8 * j8 + 4], x[8 * j8 + 5]); w.w = pk2(x[8 * j8 + 6], x[8 * j8 + 7]);
                *(v4u*)(gUT + cidx * 64 + 8 * j8) = w; }
        } else { const int kc = cidx - 64;
#pragma unroll
            for (int j = 0; j < 64; ++j) gWK[j * 64 + kc] = (bf16)f2bf(x[j]); }
        if (cidx == 0) ((float*)(A.ws + WS_GAM))[item] = __expf(GC[63]);
    } else {
        for (int uu_ = tid - 256; uu_ < 2048; uu_ += 256) {
            const int sub = uu_ >> 10, u2 = uu_ & 1023, item = item0 + sub;
            LAS float* Qf = (LAS float*)(lds + sub * SUBB); LAS float* Kf = Qf + 64 * 65;
            LAS float* Gs = (LAS float*)(lds + sub * SUBB + 68352); LAS float* GC = Gs + 128; LAS float* RQ = Gs + 192; LAS float* RK = Gs + 256;
            bf16* gQT = DT + TS + (size_t)item * 4096; bf16* gKDT = DT + 3 * TS + (size_t)item * 4096;
            const float gl = GC[63];
            if (u2 < 512) { const int i = u2 >> 3, k8 = (u2 & 7) * 8; const float sc = RQ[i] * __expf(GC[i]); float q[8];
#pragma unroll
                for (int d = 0; d < 8; ++d) q[d] = Qf[i * 65 + k8 + d] * sc;
                v4u w; w.x = pk2(q[0], q[1]); w.y = pk2(q[2], q[3]); w.z = pk2(q[4], q[5]); w.w = pk2(q[6], q[7]); *(v4u*)(gQT + i * 64 + k8) = w;
            } else { const int uu = u2 - 512, k = uu >> 3, j8 = (uu & 7) * 8; float q[8];
#pragma unroll
                for (int d = 0; d < 8; ++d) { const int j = j8 + d; q[d] = Kf[j * 65 + k] * RK[j] * __expf(gl - GC[j]); }
                v4u w; w.x = pk2(q[0], q[1]); w.y = pk2(q[2], q[3]); w.z = pk2(q[4], q[5]); w.w = pk2(q[6], q[7]); *(v4u*)(gKDT + k * 64 + j8) = w; }
        }
        if (c0 == 30 && tid >= 256 && tid < 448) { const int t2 = tid - 256, ten = t2 >> 6, col = ten * 384 + h * 64 + (t2 & 63); const long rl = (long)b * T + 2045;
#pragma unroll
            for (int r = 0; r < 3; ++r) A.out[O_PDCONV + (((size_t)l * 8 + b) * 3 + r) * 1152 + col] = bf2f(PROJ[(size_t)(rl + r) * NPROJ + col]); }
    }
    __syncthreads();
}

__device__ __forceinline__ void m1_gla_pair(CA& A, LAS unsigned char* lds, int l, int u, int tid, int lane, int wave) {
    constexpr int SUBB = 46080;
    const int item0 = 2 * u, bh = item0 >> 5, c0 = item0 & 31, b = bh / 6, h = bh % 6;
    const bf16* PROJ = (const bf16*)(A.ws + WS_PROJ); bf16* HEADS = (bf16*)(A.ws + WS_XN);
    const int i = tid >> 3, p = tid & 7;
    f32x4 w2v[16];
#pragma unroll
    for (int r = 0; r < 16; ++r) w2v[r] = *(const f32x4*)(A.in[20] + ((size_t)l * 16 + r) * 192 + h * 32 + 4 * p);
    const f32x4 b2v = *(const f32x4*)(A.in[21] + l * 192 + h * 32 + 4 * p);
#pragma unroll
    for (int sub = 0; sub < 2; ++sub) {
        LAS float* BC = (LAS float*)(lds + sub * SUBB + 2304);
        const size_t pr = ((size_t)b * T + (c0 + sub) * 64 + i) * NPROJ;
        float lc[16];
        const v4u l0 = *(const v4u*)(PROJ + pr + C_LC), l1 = *(const v4u*)(PROJ + pr + C_LC + 8);
        const unsigned lw[8] = {l0.x, l0.y, l0.z, l0.w, l1.x, l1.y, l1.z, l1.w};
#pragma unroll
        for (int r = 0; r < 8; ++r) { lc[2 * r] = __uint_as_float(lw[r] << 16); lc[2 * r + 1] = __uint_as_float(lw[r] & 0xffff0000u); }
#pragma unroll
        for (int d = 0; d < 4; ++d) { const int k = 4 * p + d; float lg = b2v[d];
#pragma unroll
            for (int r = 0; r < 16; ++r) lg += lc[r] * w2v[r][d];
            BC[i * 33 + k] = -softplusf(-lg) * (1.f / 16.f); }
    }
    __syncthreads();
    { const int k = tid & 31, sg = tid >> 5;
#pragma unroll
      for (int sub = 0; sub < 2; ++sub) { LAS float* BC = (LAS float*)(lds + sub * SUBB + 2304); LAS float* SEG = (LAS float*)(lds + sub * SUBB + 44032);
          SEG[sg * 32 + k] = (BC[(4 * sg) * 33 + k] + BC[(4 * sg + 1) * 33 + k]) + (BC[(4 * sg + 2) * 33 + k] + BC[(4 * sg + 3) * 33 + k]); } }
    __syncthreads();
#pragma unroll
    for (int sub = 0; sub < 2; ++sub) {
        const int item = item0 + sub;
        bf16* gQ = (bf16*)(A.ws + WS_GQ) + (size_t)item * 2048; float* gD = (float*)(A.ws + WS_GD) + (size_t)item * 32;
        LAS float* BC = (LAS float*)(lds + sub * SUBB + 2304); LAS float* SEG = (LAS float*)(lds + sub * SUBB + 44032);
        LAS bf16* Qb = (LAS bf16*)(lds + sub * SUBB + 10752); LAS bf16* Kb = (LAS bf16*)(lds + sub * SUBB + 15872); LAS bf16* KDt = (LAS bf16*)(lds + sub * SUBB + 20992); LAS bf16* Vt = (LAS bf16*)(lds + sub * SUBB + 25600);
        const size_t pr = ((size_t)b * T + (c0 + sub) * 64 + i) * NPROJ;
        const v2u qw = *(const v2u*)(PROJ + pr + C_QC + h * 32 + 4 * p), kw = *(const v2u*)(PROJ + pr + C_KC + h * 32 + 4 * p);
        const float qv[4] = {__uint_as_float(qw.x << 16), __uint_as_float(qw.x & 0xffff0000u), __uint_as_float(qw.y << 16), __uint_as_float(qw.y & 0xffff0000u)};
        const float kv[4] = {__uint_as_float(kw.x << 16), __uint_as_float(kw.x & 0xffff0000u), __uint_as_float(kw.y << 16), __uint_as_float(kw.y & 0xffff0000u)};
        float qt[4], kt[4];
#pragma unroll
        for (int d = 0; d < 4; ++d) { const int k = 4 * p + d; float bb = 0.f, bl = 0.f;
#pragma unroll
            for (int q = 0; q < 16; ++q) { const float sq = SEG[q * 32 + k]; bl += sq; if (q < (i >> 2)) bb += sq; }
#pragma unroll
            for (int q = 0; q < 4; ++q) { const float f = BC[(4 * (i >> 2) + q) * 33 + k]; if (q <= (i & 3)) bb += f; }
            qt[d] = qv[d] * 0.17677669529663687f * __expf(bb); kt[d] = kv[d] * __expf(-bb); KDt[k * 72 + i] = (bf16)f2bf(kv[d] * __expf(bl - bb)); }
        v2u w; w.x = pk2(qt[0], qt[1]); w.y = pk2(qt[2], qt[3]); *(LAS v2u*)(Qb + i * 40 + 4 * p) = w; *(v2u*)(gQ + i * 32 + 4 * p) = w;
        w.x = pk2(kt[0], kt[1]); w.y = pk2(kt[2], kt[3]); *(LAS v2u*)(Kb + i * 40 + 4 * p) = w;
        const v4u vw = *(const v4u*)(PROJ + pr + C_VC + h * 64 + 8 * p); const unsigned vws[4] = {vw.x, vw.y, vw.z, vw.w};
#pragma unroll
        for (int d = 0; d < 4; ++d) { Vt[(8 * p + 2 * d) * 72 + i] = (bf16)(vws[d] & 0xffffu); Vt[(8 * p + 2 * d + 1) * 72 + i] = (bf16)(vws[d] >> 16); }
        if (tid < 32) { float tl = 0.f;
#pragma unroll
            for (int q = 0; q < 16; ++q) tl += SEG[q * 32 + tid];
            gD[tid] = __expf(tl); }
    }
    __syncthreads();
#pragma unroll
    for (int s = 0; s < 4; ++s) {
        const int t = 4 * wave + s, sub = t >> 4, at = (t >> 2) & 3, bt = t & 3; const int ii = 16 * bt + (lane & 15), j0 = 16 * at + 4 * (lane >> 4);
        LAS bf16* Qb = (LAS bf16*)(lds + sub * SUBB + 10752); LAS bf16* Kb = (LAS bf16*)(lds + sub * SUBB + 15872); LAS bf16* ATb = (LAS bf16*)(lds + sub * SUBB + 34816);
        f32x4 acc = (f32x4){0.f, 0.f, 0.f, 0.f};
        if (at <= bt) acc = mma_lds<32>(Kb + at * 16 * 40, 40, Qb + bt * 16 * 40, 40, acc, lane);
        float o[4];
#pragma unroll
        for (int e = 0; e < 4; ++e) o[e] = (j0 + e <= ii) ? acc[e] : 0.f;
        v2u w; w.x = pk2(o[0], o[1]); w.y = pk2(o[2], o[3]); *(LAS v2u*)(ATb + ii * 72 + j0) = w;
    }
    __syncthreads();
#pragma unroll
    for (int s = 0; s < 4; ++s) {
        const int t = 4 * wave + s, sub = t >> 4, at = (t >> 2) & 3, bt = t & 3; const int ii = 16 * bt + (lane & 15), v0 = 16 * at + 4 * (lane >> 4);
        LAS bf16* Vt = (LAS bf16*)(lds + sub * SUBB + 25600); LAS bf16* ATb = (LAS bf16*)(lds + sub * SUBB + 34816);
        f32x4 acc = (f32x4){0.f, 0.f, 0.f, 0.f};
        acc = mma_lds<64>(Vt + at * 16 * 72, 72, ATb + bt * 16 * 72, 72, acc, lane);
        v2u w; w.x = pk2(acc[0], acc[1]); w.y = pk2(acc[2], acc[3]); *(v2u*)(HEADS + ((size_t)b * T + (c0 + sub) * 64 + ii) * D + 640 + h * 64 + v0) = w;
    }
#pragma unroll
    for (int s = 0; s < 2; ++s) {
        const int t = 2 * wave + s, sub = t >> 3, at = (t >> 2) & 1, bt = t & 3; const int v = 16 * bt + (lane & 15), k0 = 16 * at + 4 * (lane >> 4);
        LAS bf16* KDt = (LAS bf16*)(lds + sub * SUBB + 20992); LAS bf16* Vt = (LAS bf16*)(lds + sub * SUBB + 25600);
        float* gU = (float*)(A.ws + WS_GU) + (size_t)(item0 + sub) * 2048;
        f32x4 acc = (f32x4){0.f, 0.f, 0.f, 0.f};
        acc = mma_lds<64>(KDt + at * 16 * 72, 72, Vt + bt * 16 * 72, 72, acc, lane);
        *(f32x4*)(gU + v * 32 + k0) = acc;
    }
    __syncthreads();
}

__device__ __forceinline__ void m2_delta(CA& A, LAS unsigned char* lds, int l, int bh, int tid, int lane, int wave) {
    const int b = bh / 6, h = bh % 6;
    const bf16* PROJ = (const bf16*)(A.ws + WS_PROJ); bf16* HEADS = (bf16*)(A.ws + WS_XN);
    const bf16* DT = (const bf16*)(A.ws + WS_DT); constexpr size_t TS = (size_t)1536 * 4096; const float* GAM = (const float*)(A.ws + WS_GAM);
    LAS bf16* St = (LAS bf16*)lds;
    LAS bf16* Wt = St + 2 * 4608;
    LAS bf16* TB = Wt + 4608;
    const int lrow = tid >> 3, lc8 = (tid & 7) * 8;
    for (int u = tid; u < 4608 / 2; u += NTHR) ((LAS unsigned*)St)[u] = 0u;
    f32x4 Sreg[4];
#pragma unroll
    for (int kt = 0; kt < 4; ++kt) Sreg[kt] = (f32x4){0.f, 0.f, 0.f, 0.f};
    v4u nx[5];
    { const bf16* src = DT + (size_t)(bh * 32) * 4096 + lrow * 64 + lc8;
#pragma unroll
      for (int q = 0; q < 5; ++q) nx[q] = *(const v4u*)(src + q * TS);
#pragma unroll
      for (int q = 0; q < 5; ++q) *(LAS v4u*)(TB + q * 4608 + lrow * 72 + lc8) = nx[q]; }
    __syncthreads();
    for (int c = 0; c < 32; ++c) {
        const int cur = c & 1, item = bh * 32 + c;
        LAS bf16* Sc = St + cur * 4608; LAS bf16* Sn = St + (cur ^ 1) * 4608;
        LAS bf16* tWK = TB + cur * 5 * 4608; LAS bf16* tQT = tWK + 4608; LAS bf16* tATT = tQT + 4608; LAS bf16* tKDT = tATT + 4608; LAS bf16* tUT = tKDT + 4608;
        if (c + 1 < 32) { const bf16* src = DT + (size_t)(item + 1) * 4096 + lrow * 64 + lc8;
#pragma unroll
            for (int q = 0; q < 5; ++q) nx[q] = *(const v4u*)(src + q * TS); }
        const float gam = GAM[item];
        v2u zpre[4];
        if (wave < 4) { const size_t rowz = (size_t)b * T + c * 64 + 16 * wave + (lane & 15);
#pragma unroll
            for (int vt = 0; vt < 4; ++vt) zpre[vt] = *(const v2u*)(PROJ + rowz * NPROJ + C_ZA + h * 64 + 16 * vt + 4 * (lane >> 4)); }
#pragma unroll
        for (int s = 0; s < 2; ++s) {
            const int t = 2 * wave + s, jt = t & 3, vt = t >> 2;
            f32x4 acc = (f32x4){0.f, 0.f, 0.f, 0.f};
            acc = mma_lds<64>(tWK + jt * 16 * 72, 72, Sc + vt * 16 * 72, 72, acc, lane);
            const int v = 16 * vt + (lane & 15), j0 = 16 * jt + 4 * (lane >> 4);
            const v2u uw = *(const LAS v2u*)(tUT + v * 72 + j0);
            const float w0 = __uint_as_float(uw.x << 16) - acc[0], w1 = __uint_as_float(uw.x & 0xffff0000u) - acc[1], w2 = __uint_as_float(uw.y << 16) - acc[2], w3 = __uint_as_float(uw.y & 0xffff0000u) - acc[3];
            v2u w; w.x = pk2(w0, w1); w.y = pk2(w2, w3); *(LAS v2u*)(Wt + v * 72 + j0) = w;
        }
        __syncthreads();
        if (wave < 4) {
            const int it = wave; f32x4 o[4]; float ss = 0.f;
#pragma unroll
            for (int vt = 0; vt < 4; ++vt) { o[vt] = (f32x4){0.f, 0.f, 0.f, 0.f};
                o[vt] = mma_lds<64>(Sc + vt * 16 * 72, 72, tQT + it * 16 * 72, 72, o[vt], lane);
                o[vt] = mma_lds<64>(Wt + vt * 16 * 72, 72, tATT + it * 16 * 72, 72, o[vt], lane);
                ss += (o[vt][0] * o[vt][0] + o[vt][1] * o[vt][1]) + (o[vt][2] * o[vt][2] + o[vt][3] * o[vt][3]); }
            ss += shx(ss, 16, lane); ss += shx(ss, 32, lane);
            const float rinv = rsqrtf(ss * (1.f / 64.f) + EPS);
            const size_t row = (size_t)b * T + c * 64 + 16 * it + (lane & 15);
#pragma unroll
            for (int vt = 0; vt < 4; ++vt) { const int v0 = 16 * vt + 4 * (lane >> 4);
                const v2u zw = zpre[vt]; const f32x4 nw = *(const f32x4*)(A.in[12] + l * 64 + v0);
                const float z0 = __uint_as_float(zw.x << 16), z1 = __uint_as_float(zw.x & 0xffff0000u), z2 = __uint_as_float(zw.y << 16), z3 = __uint_as_float(zw.y & 0xffff0000u);
                v2u w; w.x = pk2(o[vt][0] * rinv * nw[0] * siluf(z0), o[vt][1] * rinv * nw[1] * siluf(z1)); w.y = pk2(o[vt][2] * rinv * nw[2] * siluf(z2), o[vt][3] * rinv * nw[3] * siluf(z3));
                *(v2u*)(HEADS + row * D + h * 64 + v0) = w; }
        } else {
            const int vt = wave - 4, v = 16 * vt + (lane & 15);
#pragma unroll
            for (int kt = 0; kt < 4; ++kt) { Sreg[kt] = Sreg[kt] * gam;
                Sreg[kt] = mma_lds<64>(tKDT + kt * 16 * 72, 72, Wt + vt * 16 * 72, 72, Sreg[kt], lane);
                v2u w; w.x = pk2(Sreg[kt][0], Sreg[kt][1]); w.y = pk2(Sreg[kt][2], Sreg[kt][3]); *(LAS v2u*)(Sn + v * 72 + 16 * kt + 4 * (lane >> 4)) = w; }
        }
        if (c + 1 < 32) { LAS bf16* dst = TB + (cur ^ 1) * 5 * 4608 + lrow * 72 + lc8;
#pragma unroll
            for (int q = 0; q < 5; ++q) *(LAS v4u*)(dst + q * 4608) = nx[q]; }
        __syncthreads();
    }
    if (wave >= 4) { const int vt = wave - 4, v = 16 * vt + (lane & 15); float* So = A.out + O_PDELTA + (((size_t)l * 8 + b) * 6 + h) * 4096;
#pragma unroll
        for (int kt = 0; kt < 4; ++kt)
#pragma unroll
            for (int e = 0; e < 4; ++e) So[(16 * kt + 4 * (lane >> 4) + e) * 64 + v] = Sreg[kt][e]; }
    __syncthreads();
}
__device__ __forceinline__ void m2_gla(CA& A, LAS unsigned char* lds, int l, int bh, int tid, int lane, int wave) {
    const int b = bh / 6, h = bh % 6;
    const bf16* PROJ = (const bf16*)(A.ws + WS_PROJ); bf16* HEADS = (bf16*)(A.ws + WS_XN);
    const bf16* gQ = (const bf16*)(A.ws + WS_GQ) + (size_t)bh * 32 * 2048; const float* gU = (const float*)(A.ws + WS_GU) + (size_t)bh * 32 * 2048; const float* gD = (const float*)(A.ws + WS_GD) + (size_t)bh * 32 * 32;
    LAS bf16* SbB = (LAS bf16*)lds;
    LAS bf16* QbB = SbB + 2 * 64 * 40;
    const int v = tid >> 3, k4 = (tid & 7) * 4;
    f32x4 S = (f32x4){0.f, 0.f, 0.f, 0.f};
    v4u qn = (v4u){0u, 0u, 0u, 0u}; f32x4 un, dn;
    if (tid < 256) qn = *(const v4u*)(gQ + tid * 8);
    un = *(const f32x4*)(gU + v * 32 + k4); dn = *(const f32x4*)(gD + k4);
    const f32x4 nw0 = *(const f32x4*)(A.in[22] + l * 64 + 4 * (lane >> 4)), nw1 = *(const f32x4*)(A.in[22] + l * 64 + 16 + 4 * (lane >> 4)), nw2 = *(const f32x4*)(A.in[22] + l * 64 + 32 + 4 * (lane >> 4)), nw3 = *(const f32x4*)(A.in[22] + l * 64 + 48 + 4 * (lane >> 4));
    v2u on[4], zn[4];
    if (wave < 4) { const size_t row = (size_t)b * T + 16 * wave + (lane & 15);
#pragma unroll
        for (int vt = 0; vt < 4; ++vt) { const int v0 = 16 * vt + 4 * (lane >> 4); on[vt] = *(const v2u*)(HEADS + row * D + 640 + h * 64 + v0); zn[vt] = *(const v2u*)(PROJ + row * NPROJ + C_ZC + h * 64 + v0); } }
    for (int c = 0; c < 32; ++c) {
        const int cur = c & 1; LAS bf16* Sb = SbB + cur * 64 * 40; LAS bf16* Qb = QbB + cur * 64 * 40;
        const v4u qc = qn; const f32x4 uc = un, dc = dn;
        v2u oc[4], zc[4];
#pragma unroll
        for (int vt = 0; vt < 4; ++vt) { oc[vt] = on[vt]; zc[vt] = zn[vt]; }
        if (c + 1 < 32) { if (tid < 256) qn = *(const v4u*)(gQ + (size_t)(c + 1) * 2048 + tid * 8); un = *(const f32x4*)(gU + (size_t)(c + 1) * 2048 + v * 32 + k4); dn = *(const f32x4*)(gD + (c + 1) * 32 + k4);
            if (wave < 4) { const size_t row = (size_t)b * T + (c + 1) * 64 + 16 * wave + (lane & 15);
#pragma unroll
                for (int vt = 0; vt < 4; ++vt) { const int v0 = 16 * vt + 4 * (lane >> 4); on[vt] = *(const v2u*)(HEADS + row * D + 640 + h * 64 + v0); zn[vt] = *(const v2u*)(PROJ + row * NPROJ + C_ZC + h * 64 + v0); } } }
        { v2u w; w.x = pk2(S[0], S[1]); w.y = pk2(S[2], S[3]); *(LAS v2u*)(Sb + v * 40 + k4) = w; }
        if (tid < 256) *(LAS v4u*)(Qb + (tid >> 2) * 40 + (tid & 3) * 8) = qc;
        __syncthreads();
        if (wave < 4) {
            const int it = wave; f32x4 o[4]; float ss = 0.f;
            const size_t row = (size_t)b * T + c * 64 + 16 * it + (lane & 15);
#pragma unroll
            for (int vt = 0; vt < 4; ++vt) {
                o[vt] = (f32x4){__uint_as_float(oc[vt].x << 16), __uint_as_float(oc[vt].x & 0xffff0000u), __uint_as_float(oc[vt].y << 16), __uint_as_float(oc[vt].y & 0xffff0000u)};
                o[vt] = mma_lds<32>(Sb + vt * 16 * 40, 40, Qb + it * 16 * 40, 40, o[vt], lane);
                ss += (o[vt][0] * o[vt][0] + o[vt][1] * o[vt][1]) + (o[vt][2] * o[vt][2] + o[vt][3] * o[vt][3]); }
            ss += shx(ss, 16, lane); ss += shx(ss, 32, lane);
            const float rinv = rsqrtf(ss * (1.f / 64.f) + EPS);
#pragma unroll
            for (int vt = 0; vt < 4; ++vt) { const int v0 = 16 * vt + 4 * (lane >> 4);
                const v2u zw = zc[vt]; const f32x4 nw = vt == 0 ? nw0 : (vt == 1 ? nw1 : (vt == 2 ? nw2 : nw3));
                const float z0 = __uint_as_float(zw.x << 16), z1 = __uint_as_float(zw.x & 0xffff0000u), z2 = __uint_as_float(zw.y << 16), z3 = __uint_as_float(zw.y & 0xffff0000u);
                v2u w; w.x = pk2(o[vt][0] * rinv * nw[0] * siluf(z0), o[vt][1] * rinv * nw[1] * siluf(z1)); w.y = pk2(o[vt][2] * rinv * nw[2] * siluf(z2), o[vt][3] * rinv * nw[3] * siluf(z3));
                *(v2u*)(HEADS + row * D + 640 + h * 64 + v0) = w; }
        }
        S = dc * S + uc;
    }
    float* So = A.out + O_PGLA + (((size_t)l * 8 + b) * 6 + h) * 2048;
#pragma unroll
    for (int e = 0; e < 4; ++e) So[(k4 + e) * 64 + v] = S[e];
    __syncthreads();
}

__device__ __forceinline__ void m2_lru(CA& A, LAS unsigned char* lds, int l, int u, int tid, int lane, int wave) {
    const int b = u >> 2, blk = u & 3, ch = tid & 63, g = tid >> 6, cg = blk * 64 + ch;
    const bf16* PROJ = (const bf16*)(A.ws + WS_PROJ); bf16* HEADS = (bf16*)(A.ws + WS_XN);
    LAS bf16* Wr = (LAS bf16*)lds; LAS bf16* Wi = Wr + 64 * 72; LAS bf16* XCb = Wi + 64 * 72;
    LAS float* XC = (LAS float*)(lds + 27648); LAS float* AA = XC + 64 * 65; LAS float* BX = AA + 64 * 65; LAS float* SEGP = BX + 64 * 65; LAS float* SEGH = SEGP + 512;
#pragma unroll
    for (int j = 0; j < 8; ++j) { const int d = 8 * g + j; const size_t wi_ = (((size_t)l * 4 + blk) * 64 + d) * 64 + ch;
        Wr[ch * 72 + d] = (bf16)f2bf(A.in[15][wi_]); Wi[ch * 72 + d] = (bf16)f2bf(A.in[17][wi_]); }
    const float* cwp = A.in[13] + (size_t)l * 4 * 256;
    const float cw0 = cwp[cg], cw1 = cwp[256 + cg], cw2 = cwp[512 + cg], cw3 = cwp[768 + cg], cbb = A.in[14][l * 256 + cg];
    float gbr[2][4], gbi[2][4], gsp[2][4];
#pragma unroll
    for (int s = 0; s < 2; ++s) { const int e0 = 16 * ((wave >> 2) * 2 + s) + 4 * (lane >> 4);
#pragma unroll
        for (int e = 0; e < 4; ++e) { const int cc = l * 256 + blk * 64 + e0 + e; gbr[s][e] = A.in[16][cc]; gbi[s][e] = A.in[18][cc]; gsp[s][e] = -8.0f * log1pf(expf(-A.in[19][cc])); } }
    float hrun = 0.f;
    float xn[11], gn[8];
    { const long row0 = (long)b * T;
#pragma unroll
      for (int r = 0; r < 11; ++r) { const int i = 8 * g - 3 + r; xn[r] = i >= 0 ? bf2f(PROJ[(size_t)(row0 + i) * NPROJ + C_XB + cg]) : 0.f; }
#pragma unroll
      for (int j = 0; j < 8; ++j) gn[j] = bf2f(PROJ[(size_t)(row0 + 8 * g + j) * NPROJ + C_GB + cg]); }
    __syncthreads();
    for (int c = 0; c < 32; ++c) {
        const long row0 = (long)b * T + c * 64;
        float xc_[8], gbv[8];
#pragma unroll
        for (int j = 0; j < 8; ++j) { xc_[j] = xn[j] * cw0 + xn[j + 1] * cw1 + xn[j + 2] * cw2 + xn[j + 3] * cw3 + cbb; gbv[j] = gn[j]; }
        if (c + 1 < 32) {
#pragma unroll
            for (int r = 0; r < 11; ++r) xn[r] = bf2f(PROJ[(size_t)(row0 + 64 + 8 * g - 3 + r) * NPROJ + C_XB + cg]);
#pragma unroll
            for (int j = 0; j < 8; ++j) gn[j] = bf2f(PROJ[(size_t)(row0 + 64 + 8 * g + j) * NPROJ + C_GB + cg]); }
#pragma unroll
        for (int j = 0; j < 8; ++j) { XC[(8 * g + j) * 65 + ch] = xc_[j]; XCb[(8 * g + j) * 72 + ch] = (bf16)f2bf(xc_[j]); }
        __syncthreads();
        { const int it = wave & 3, i = 16 * it + (lane & 15);
#pragma unroll
          for (int s = 0; s < 2; ++s) { const int et = (wave >> 2) * 2 + s, e0 = 16 * et + 4 * (lane >> 4);
            f32x4 ar = (f32x4){0.f, 0.f, 0.f, 0.f}, ai = ar;
            ar = mma_lds<64>(Wr + et * 16 * 72, 72, XCb + it * 16 * 72, 72, ar, lane);
            ai = mma_lds<64>(Wi + et * 16 * 72, 72, XCb + it * 16 * 72, 72, ai, lane);
#pragma unroll
            for (int e = 0; e < 4; ++e) { const float r = sigm(ar[e] + gbr[s][e]), ig = sigm(ai[e] + gbi[s][e]); const float la = r * gsp[s][e];
                const float a = __expf(la); AA[i * 65 + e0 + e] = a; BX[i * 65 + e0 + e] = __builtin_amdgcn_sqrtf((1.0f - a) * (1.0f + a)) * ig * XC[i * 65 + e0 + e]; } } }
        __syncthreads();
        float av[8], bv[8]; float hl = 0.f, pl = 1.f;
#pragma unroll
        for (int j = 0; j < 8; ++j) { av[j] = AA[(8 * g + j) * 65 + ch]; bv[j] = BX[(8 * g + j) * 65 + ch]; hl = av[j] * hl + bv[j]; pl *= av[j]; }
        SEGP[g * 64 + ch] = pl; SEGH[g * 64 + ch] = hl;
        __syncthreads();
        float hin = hrun, hall = hrun;
#pragma unroll
        for (int q = 0; q < 8; ++q) { const float p = SEGP[q * 64 + ch], hh = SEGH[q * 64 + ch]; hall = p * hall + hh; if (q < g) hin = hall; }
        hrun = hall;
#pragma unroll
        for (int j = 0; j < 8; ++j) { hin = av[j] * hin + bv[j]; HEADS[(size_t)(row0 + 8 * g + j) * D + 384 + cg] = (bf16)f2bf(hin * gelu_t(gbv[j])); }
    }
    if (wave == 0) { A.out[O_PLRU + ((size_t)l * 8 + b) * 256 + cg] = hrun;
#pragma unroll
        for (int r = 0; r < 3; ++r) A.out[O_PLCONV + (((size_t)l * 8 + b) * 3 + r) * 256 + cg] = bf2f(PROJ[((size_t)b * T + 2045 + r) * NPROJ + C_XB + cg]); }
    __syncthreads();
}

__device__ __forceinline__ void lru_sample_wg(CA& A, LAS unsigned char* lds, int l, int u, int tid, int lane, int wave) {
    const int grp = u >> 2, blk = u & 3, ch = tid & 63, g = tid >> 6, cg = blk * 64 + ch, bs = grp * 8 + g;
    const bf16* PROJ = (const bf16*)(A.ws + WS_PROJ); bf16* HEADS = (bf16*)(A.ws + WS_XN);
    LAS bf16* Wr = (LAS bf16*)lds; LAS bf16* Wi = Wr + 64 * 72; LAS bf16* XCb = Wi + 64 * 72;
    LAS float* XC = (LAS float*)(lds + 27648); LAS float* AA = XC + 64 * 65; LAS float* BX = AA + 64 * 65; LAS float* HO = BX + 64 * 65;
#pragma unroll
    for (int j = 0; j < 8; ++j) { const int d = 8 * g + j; const size_t wi_ = (((size_t)l * 4 + blk) * 64 + d) * 64 + ch;
        Wr[ch * 72 + d] = (bf16)f2bf(A.in[15][wi_]); Wi[ch * 72 + d] = (bf16)f2bf(A.in[17][wi_]); }
    const float* cwp = A.in[13] + (size_t)l * 4 * 256;
    const float cw0 = cwp[cg], cw1 = cwp[256 + cg], cw2 = cwp[512 + cg], cw3 = cwp[768 + cg], cbb = A.in[14][l * 256 + cg];
    const size_t row0 = (size_t)MP + grp * 64;
    float xn[11], gbv[8];
    const float* cs = A.in[4] + ((size_t)l * 128 + bs) * 3 * 256;
    xn[0] = cs[cg]; xn[1] = cs[256 + cg]; xn[2] = cs[512 + cg];
#pragma unroll
    for (int j = 0; j < 8; ++j) { xn[3 + j] = bf2f(PROJ[(row0 + 8 * g + j) * NPROJ + C_XB + cg]); gbv[j] = bf2f(PROJ[(row0 + 8 * g + j) * NPROJ + C_GB + cg]); }
#pragma unroll
    for (int j = 0; j < 8; ++j) { const float xc = xn[j] * cw0 + xn[j + 1] * cw1 + xn[j + 2] * cw2 + xn[j + 3] * cw3 + cbb; XC[(8 * g + j) * 65 + ch] = xc; XCb[(8 * g + j) * 72 + ch] = (bf16)f2bf(xc); }
#pragma unroll
    for (int r = 0; r < 3; ++r) A.out[O_SLCONV + (((size_t)l * 128 + bs) * 3 + r) * 256 + cg] = xn[8 + r];
    __syncthreads();
    { const int it = wave & 3, i = 16 * it + (lane & 15);
#pragma unroll
      for (int s = 0; s < 2; ++s) { const int et = (wave >> 2) * 2 + s, e0 = 16 * et + 4 * (lane >> 4);
        f32x4 ar = (f32x4){0.f, 0.f, 0.f, 0.f}, ai = ar;
        ar = mma_lds<64>(Wr + et * 16 * 72, 72, XCb + it * 16 * 72, 72, ar, lane);
        ai = mma_lds<64>(Wi + et * 16 * 72, 72, XCb + it * 16 * 72, 72, ai, lane);
        const f32x4 br = *(const f32x4*)(A.in[16] + l * 256 + blk * 64 + e0), bi = *(const f32x4*)(A.in[18] + l * 256 + blk * 64 + e0), lam = *(const f32x4*)(A.in[19] + l * 256 + blk * 64 + e0);
#pragma unroll
        for (int e = 0; e < 4; ++e) { const float r = sigm(ar[e] + br[e]), ig = sigm(ai[e] + bi[e]); const float la = -8.0f * r * log1pf(expf(-lam[e]));
            AA[i * 65 + e0 + e] = expf(la); BX[i * 65 + e0 + e] = sqrtf(-expm1f(2.0f * la)) * ig * XC[i * 65 + e0 + e]; } } }
    __syncthreads();
    { float h = A.in[5][((size_t)l * 128 + bs) * 256 + cg];
#pragma unroll
      for (int j = 0; j < 8; ++j) { const int i = 8 * g + j; h = AA[i * 65 + ch] * h + BX[i * 65 + ch]; HEADS[(row0 + i) * D + 384 + cg] = (bf16)f2bf(h * gelu_t(gbv[j])); }
      A.out[O_SLRU + ((size_t)l * 128 + bs) * 256 + cg] = h; }
    __syncthreads();
}

#define XB_TMO      128
#define XB_XCNT(j)  (256  + 64 * (j))
#define XB_XSUB(j)  (1280 + 64 * (j))
#define XB_XGEN(j)  (2304 + 64 * (j))
#define XB_TOP      3328
#define XB_TOPGEN   3392
#define XCD_BAR_WORDS 3456
#define XB_SPIN_CAP (1u << 18)

__device__ __forceinline__ unsigned xb_ld(unsigned* p)              { return __hip_atomic_load(p, __ATOMIC_RELAXED, __HIP_MEMORY_SCOPE_AGENT); }
__device__ __forceinline__ unsigned xb_add(unsigned* p, unsigned v) { return __hip_atomic_fetch_add(p, v, __ATOMIC_RELAXED, __HIP_MEMORY_SCOPE_AGENT); }
__device__ __forceinline__ unsigned xb_xcc_id() { return (unsigned)__builtin_amdgcn_s_getreg((3 << 11) | 20) & 0xFu; }
#define XB_SPIN(cond, bar) do { unsigned _sp = 0; while (cond) { __builtin_amdgcn_s_sleep(1); \
    if ((++_sp & 255u) == 0u) { if (xb_ld(&(bar)[XB_TMO])) break; if (_sp > XB_SPIN_CAP) { atomicAdd(&(bar)[XB_TMO], 1u); break; } } } } while (0)

struct XcdBarrier {
    unsigned* bar; unsigned x;
    volatile LAS unsigned* st;
};

__device__ __forceinline__ XcdBarrier xcd_barrier_post(unsigned* bar, volatile LAS unsigned* st, const bool leader) {
    XcdBarrier b; b.bar = bar; b.x = xb_xcc_id(); b.st = st;
    if (leader) (void)xb_add(&bar[XB_XCNT(b.x)], 1u);
    return b;
}
__device__ __forceinline__ void xcd_barrier_complete(unsigned* bar, unsigned x, unsigned& nloc, unsigned& nx) {
    const unsigned G = gridDim.x * gridDim.y * gridDim.z;
    unsigned sum, cnt, mine, sp = 0u;
    for (;;) {
        sum = 0u; cnt = 0u; mine = 0u;
#pragma unroll
        for (unsigned j = 0; j < 16; ++j) { const unsigned c = xb_ld(&bar[XB_XCNT(j)]); sum += c; cnt += (c > 0u) ? 1u : 0u; mine = (j == x) ? c : mine; }
        if (sum == G) break;
        __builtin_amdgcn_s_sleep(1);
        if ((++sp & 255u) == 0u) { if (xb_ld(&bar[XB_TMO])) break; if (sp > XB_SPIN_CAP) { atomicAdd(&bar[XB_TMO], 1u); break; } }
    }
    nloc = mine > 0u ? mine : 1u; nx = cnt > 0u ? cnt : 1u;
}

__device__ __forceinline__ void xcd_barrier(const XcdBarrier& b, const bool leader) {
    asm volatile("s_waitcnt vmcnt(0)" ::: "memory");
    __syncthreads();
    if (leader) {
        unsigned* bar = b.bar;
        __builtin_amdgcn_s_waitcnt(0);
        unsigned nloc = b.st[0], nx = b.st[1];
        if (nloc == 0u) { xcd_barrier_complete(bar, b.x, nloc, nx); b.st[0] = nloc; b.st[1] = nx; }
        const unsigned old = xb_add(&bar[XB_XSUB(b.x)], 1u);
        const unsigned gen = old / nloc;
        if (old + 1u == (gen + 1u) * nloc) {
            __builtin_amdgcn_fence(__ATOMIC_RELEASE, "agent");
            asm volatile("s_waitcnt vmcnt(0)" ::: "memory");
            const unsigned og = xb_add(&bar[XB_TOP], 1u);
            const unsigned tg = og / nx;
            if (og + 1u == (tg + 1u) * nx) xb_add(&bar[XB_TOPGEN], 1u);
            else XB_SPIN(xb_ld(&bar[XB_TOPGEN]) == tg, bar);
            __builtin_amdgcn_fence(__ATOMIC_ACQUIRE, "agent");
            xb_add(&bar[XB_XGEN(b.x)], 1u);
            asm volatile("s_waitcnt vmcnt(0)" ::: "memory");
        } else {
            XB_SPIN(xb_ld(&bar[XB_XGEN(b.x)]) == gen, bar);
            __builtin_amdgcn_fence(__ATOMIC_ACQUIRE, "agent");
            asm volatile("s_waitcnt vmcnt(0)" ::: "memory");
        }
    }
    __syncthreads();
}

#define FRESHA() CA* Aq = Ap; asm volatile("" : "+s"(Aq)); CA& A = *Aq;
#define FRESH() int tid = wave * 64 + fresh_lane(); asm volatile("" : "+v"(tid)); const int lane = tid & 63; (void)lane; LAS unsigned char* lds = lds0; asm volatile("" : "+v"(lds)); (void)lds; FRESHA();
#ifndef PH
#define PH 0xffff
#endif
#ifndef REP_M1
#define REP_M1 1
#endif
#ifndef REP_M2
#define REP_M2 1
#endif
#ifndef REP_G1
#define REP_G1 1
#endif
#ifndef REP_G3
#define REP_G3 1
#endif
#define GSYNC() do { XcdBarrier xb_; xb_.bar = (unsigned*)Ap->ws + 4096; xb_.x = xb_xcc_id(); const unsigned ln_ = (unsigned)fresh_lane(); LAS unsigned char* lb_ = lds0; asm volatile("" : "+v"(lb_)); xb_.st = (volatile LAS unsigned*)(lb_ + 147392); xcd_barrier(xb_, wave == 0 && ln_ == 0u); } while (0)
template <int l> __device__ __forceinline__ void layer_body(CA* Ap, LAS unsigned char* lds0, const int wave, const int bid, const int G, const int gw, const int NGW) {
        for (int rep = 0; rep < REP_G1; ++rep) if (PH & 1) { FRESHA(); pg8::Gemm g{(const bf16*)(A.ws + WS_XN), (const bf16*)(A.ws + WS_WIN), M, NPROJ, D}; pg8::StaticOrder S; S.init(M, NPROJ, G, bid);
          pg8::EpiProj E{(bf16*)(A.ws + WS_PROJ), NPROJ};
          pg8::gemm_phase<pg8::EpiProj, pg8::StaticOrder, true, true>(lds0, g, S, E, wave); }
        GSYNC();
        for (int rep = 0; rep < REP_M1; ++rep) {
            for (int u = bid; u < 768 + 768; u += G) { FRESH(); if (u < 768) { if (PH & 8) m1_delta_pair(A, lds, l, u, tid, lane, wave); } else { if (PH & 16) m1_gla_pair(A, lds, l, u - 768, tid, lane, wave); } }
        }
        GSYNC();
        {
            for (int rep = 0; rep < REP_M2; ++rep) for (int u = bid; u < 128; u += G) { FRESH(); if (u < 48) { if (PH & 32) m2_delta(A, lds, l, u, tid, lane, wave); } else if (u < 96) { if ((PH & 64) && rep == 0) m2_gla(A, lds, l, u - 48, tid, lane, wave); } else { if (PH & 128) m2_lru(A, lds, l, u - 96, tid, lane, wave); } __syncthreads(); }
            if (PH & 2) for (int u = bid - 128; u >= 0 && u < 64; u += (G > 128 ? G - 128 : G)) { FRESH(); lru_sample_wg(A, lds, l, u, tid, lane, wave); }
            int li, ln; if (G > 128) { li = (bid - 128) * NWAVES + wave; ln = (G - 128) * NWAVES; } else { li = gw; ln = NGW; }
            if (li >= 0) {
                if (PH & 4) for (int it = li; it < 1536; it += ln) { FRESH(); if (it < 768) sample_delta_item(A, l, it, lane); else sample_gla_item(A, l, it - 768, lane); }
            }
            if (G == 256 ? (bid < 96 || bid >= 128) : true) { FRESH();
                const int ci = G == 256 ? ((bid < 96 ? bid : bid - 32) * NWAVES + wave) : gw, cn = G == 256 ? 224 * NWAVES : NGW;
                convert_weights(A, lds, l, CONV_IN, CONV_ALL, ci, cn, wave, lane); }
        }
        GSYNC();
        if (PH & 256) { FRESHA(); float* XF = A.out; pg8::Gemm g{(const bf16*)(A.ws + WS_XN), (const bf16*)(A.ws + WS_WOUT), M, D, D}; pg8::TailOrder S; S.init(G, bid, D);
          pg8::EpiResidT<false, true> E{l == 0 ? A.in[0] : XF, XF, ALPHA, (float*)(A.ws + WS_PART), 4, nullptr, (pg8::bf16_t*)(A.ws + WS_YB1)};
          pg8::gemm_phase<pg8::EpiResidT<false, true>, pg8::TailOrder, true, true>(lds0, g, S, E, wave); }
        GSYNC();
        { FRESH(); ln_pass<4, true, true>(A, A.in[24] + l * D, A.in[25] + l * D, true, false, (const float*)(A.ws + WS_PART), (const bf16*)(A.ws + WS_YB1), gw, NGW, lane); }
        GSYNC();
        for (int rep = 0; rep < REP_G3; ++rep) if (PH & 512) { FRESHA(); bf16* HB = (bf16*)(A.ws + WS_H); pg8::Gemm g{(const bf16*)(A.ws + WS_XN), (const bf16*)(A.ws + WS_WUP), M, NUP, D}; pg8::StaticOrder S; S.init(M, NUP, G, bid);
          pg8::EpiFfn E{HB, (float*)(A.ws + WS_GH), (float*)(A.ws + WS_GF), A.in[27] + (size_t)l * 3 * DFF, A.in[28] + (size_t)l * DFF, A.in[7] + (size_t)l * 128 * 2 * DFF,
                        A.out + O_PFCONV + (size_t)l * 8 * 2 * DFF, A.out + O_SFCONV + (size_t)l * 128 * 2 * DFF};
          pg8::gemm_phase<pg8::EpiFfn, pg8::StaticOrder, true, true>(lds0, g, S, E, wave); }
        GSYNC();
        if (PH & 1024) { FRESH(); float* XF = A.out; bf16* HB = (bf16*)(A.ws + WS_H); pg8::Gemm g{HB, (const bf16*)(A.ws + WS_WDN), M, D, DFF}; pg8::TailOrder S; S.init(G, bid, DFF);
          { const float* GH = (const float*)(A.ws + WS_GH); const float* GF = (const float*)(A.ws + WS_GF);
            const float* cw = A.in[27] + (size_t)l * 3 * DFF; const float* cb = A.in[28] + (size_t)l * DFF;
            pg8::Unit u;
            for (int i = 0; S.next(i, u); ++i) { if (u.pm >= 64) continue;
                f32x4 w0[2], w1[2], w2[2], bb[2];
#pragma unroll
                for (int q = 0; q < 2; ++q) { const int c = 4 * (tid + 512 * q); if (c < DFF) { w0[q] = *(const f32x4*)(cw + c); w1[q] = *(const f32x4*)(cw + DFF + c); w2[q] = *(const f32x4*)(cw + 2 * DFF + c); bb[q] = *(const f32x4*)(cb + c); } }
#pragma unroll
                for (int sl = 0; sl < 4; ++sl) { const int sp = 4 * u.pm + sl; const bool first = (sp & 31) == 0;
                    f32x4 a00[2], a01[2], a10[2], a11[2], h0[2], h1[2];
#pragma unroll
                    for (int q = 0; q < 2; ++q) { const int c = 4 * (tid + 512 * q); if (c < DFF) {
                        a00[q] = *(const f32x4*)(GF + (((size_t)sp * 2 + 0) * 2 + 0) * DFF + c); a01[q] = *(const f32x4*)(GF + (((size_t)sp * 2 + 0) * 2 + 1) * DFF + c);
                        a10[q] = *(const f32x4*)(GF + (((size_t)sp * 2 + 1) * 2 + 0) * DFF + c); a11[q] = *(const f32x4*)(GF + (((size_t)sp * 2 + 1) * 2 + 1) * DFF + c);
                        if (!first) { h0[q] = *(const f32x4*)(GH + ((size_t)(sp - 1) * 2 + 0) * DFF + c); h1[q] = *(const f32x4*)(GH + ((size_t)(sp - 1) * 2 + 1) * DFF + c); }
                        else { h0[q] = (f32x4){0.f, 0.f, 0.f, 0.f}; h1[q] = h0[q]; } } }
#pragma unroll
                    for (int q = 0; q < 2; ++q) { const int c = 4 * (tid + 512 * q); if (c < DFF) {
                        const f32x4 x0 = h0[q] * w0[q] + h1[q] * w1[q] + a00[q] * w2[q] + bb[q], x1 = h1[q] * w0[q] + a00[q] * w1[q] + a10[q] * w2[q] + bb[q];
                        v2u o0, o1;
                        o0.x = pk2(pg8::gelu_tanh_f(x0[0]) * a01[q][0], pg8::gelu_tanh_f(x0[1]) * a01[q][1]); o0.y = pk2(pg8::gelu_tanh_f(x0[2]) * a01[q][2], pg8::gelu_tanh_f(x0[3]) * a01[q][3]);
                        o1.x = pk2(pg8::gelu_tanh_f(x1[0]) * a11[q][0], pg8::gelu_tanh_f(x1[1]) * a11[q][1]); o1.y = pk2(pg8::gelu_tanh_f(x1[2]) * a11[q][2], pg8::gelu_tanh_f(x1[3]) * a11[q][3]);
                        *(v2u*)(HB + (size_t)(64 * sp) * DFF + c) = o0; *(v2u*)(HB + (size_t)(64 * sp + 1) * DFF + c) = o1; } } } }
            __threadfence(); __syncthreads(); }
          pg8::EpiResidT<true, l == 0> E{XF, XF, ALPHA, (float*)(A.ws + WS_PART), 11, (const pg8::bf16_t*)(A.ws + WS_XN), (pg8::bf16_t*)(A.ws + WS_YB2)};
          pg8::gemm_phase<pg8::EpiResidT<true, l == 0>, pg8::TailOrder, true, true>(lds0, g, S, E, wave); }
        GSYNC();
        { FRESH(); ln_pass<11, l == 0, l == 0>(A, A.in[30] + l * D, A.in[31] + l * D, l == 0, true, (const float*)(A.ws + WS_PART), (const bf16*)(A.ws + WS_YB2), gw, NGW, lane); }
        if (l == 0) { FRESH(); convert_weights(A, lds, 1, 0, CONV_IN, gw, NGW, wave, lane); }
        if (l == 0) GSYNC();
}

__global__ void __launch_bounds__(NTHR, 2) hybrid_fwd(Args Akern) {
    extern __shared__ __attribute__((aligned(16))) unsigned char lds_raw[];
    cg::grid_group grid = cg::this_grid();
    LAS unsigned char* lds0 = (LAS unsigned char*)lds_raw;
    const int tid0 = threadIdx.x, wave = __builtin_amdgcn_readfirstlane(tid0 >> 6), bid = blockIdx.x, G = gridDim.x;
    const int gw = bid * NWAVES + wave, NGW = G * NWAVES;
    CA* Ap = (CA*)__builtin_amdgcn_kernarg_segment_ptr();

    unsigned* barw = (unsigned*)Akern.ws + 4096;
    volatile LAS unsigned* bst = (volatile LAS unsigned*)(lds0 + 147392);
    if (tid0 < 2) bst[tid0] = 0u;
    (void)xcd_barrier_post(barw, bst, tid0 == 0);
    if (Akern.ws == nullptr) grid.sync();
    { FRESH(); convert_weights(A, lds, 0, 0, CONV_IN, gw, NGW, wave, lane); }
    { FRESH(); x_to_bf16(A, gw, NGW, lane); }
    GSYNC();

    layer_body<0>(Ap, lds0, wave, bid, G, gw, NGW);
    layer_body<1>(Ap, lds0, wave, bid, G, gw, NGW);
}

extern "C" void kernel_launch(void* const* d_in, const int* in_sizes, int n_in, void* d_out, int out_size, void* d_ws, size_t ws_size, hipStream_t stream) {
    static int grid = 0;
    if (grid == 0) {
        int dev = 0, cus = 0, per_cu = 0;
        if (n_in != 32 || (size_t)out_size != O_END || ws_size < 256 * MiB) { fprintf(stderr, "kernel_launch: unexpected shapes n_in %d out %d ws %zu\n", n_in, out_size, ws_size); grid = -1; return; }
        (void)hipGetDevice(&dev); (void)hipDeviceGetAttribute(&cus, hipDeviceAttributeMultiprocessorCount, dev);
        (void)hipFuncSetAttribute((const void*)hybrid_fwd, hipFuncAttributeMaxDynamicSharedMemorySize, LDS_BYTES);
        (void)hipOccupancyMaxActiveBlocksPerMultiprocessor(&per_cu, (const void*)hybrid_fwd, NTHR, LDS_BYTES);
        (void)hipGetLastError();
        if (per_cu < 1) per_cu = 1;
        grid = cus;
    }
    if (grid < 0) return;
    if (hipMemsetAsync(d_ws, 0, 65536, stream) != hipSuccess) { fprintf(stderr, "kernel_launch: hipMemsetAsync of the control words failed\n"); return; }
    Args a{};
    for (int i = 0; i < 32; ++i) a.in[i] = (const float*)d_in[i];
    a.out = (float*)d_out; a.ws = (unsigned char*)d_ws;
    void* args[] = {&a};
    hipError_t e = hipLaunchCooperativeKernel((const void*)hybrid_fwd, dim3(grid), dim3(NTHR), args, LDS_BYTES, stream);
    if (e != hipSuccess) fprintf(stderr, "cooperative launch failed: %s (grid %d)\n", hipGetErrorString(e), grid);
}
```

```cpp
#include <hip/hip_runtime.h>
#include <hip/hip_cooperative_groups.h>
#include <cstdio>
#include <cstdint>
namespace cg = cooperative_groups;
__device__ __forceinline__ int fresh_lane() { int x; asm volatile("v_mbcnt_lo_u32_b32 %0, -1, 0\n\tv_mbcnt_hi_u32_b32 %0, -1, %0" : "=v"(x)); return x; }
namespace pg8 {
#define PG8_LAS __attribute__((address_space(3)))
typedef unsigned short bf16_t;
typedef short bf16x8 __attribute__((ext_vector_type(8)));
typedef float f32x4 __attribute__((ext_vector_type(4)));
typedef unsigned u32x4 __attribute__((ext_vector_type(4)));
constexpr int BM = 256, BK = 64, HALF = 128, HTB = HALF * BK * 2  , STAGE_BYTES = 8 * HTB, NXCD = 8, WGM = 8;

__host__ __device__ __forceinline__ int lds_byte(int r, int c) { const int st = (r >> 4) * 2 + (c >> 5), rr = r & 15, cc = c & 31, ob = rr * 64 + cc * 2; return st * 1024 + (ob ^ (((ob >> 9) & 1) << 5)); }
__host__ __device__ __forceinline__ void stage_rc(int b, int& R, int& C) { const int st = b / 1024, sb = b % 1024, swz = sb ^ (((sb >> 9) & 1) << 5); R = (st >> 1) * 16 + swz / 64; C = (st & 1) * 32 + (swz % 64) / 2; }
__host__ __device__ __forceinline__ int perm32(int rho) { const int n = rho >> 4, i = rho & 15; return 8 * (i >> 2) + 4 * n + (i & 3); }

struct Unit { int pm, pn, k0, nt; };
struct Gemm { const bf16_t* A; const bf16_t* Bt; int M, N, K; };

struct StaticOrder {
    int nM, nN, nwg, G, c, knt;
    __host__ __device__ __forceinline__ void init(int M, int N, int G_, int c_, int K_ = 1024) { nM = M / BM; nN = N / BM; nwg = nM * nN; G = G_; c = c_; knt = K_ / BK; }
    __host__ __device__ __forceinline__ bool next(int i, Unit& u) const {
        const long L = (long)i * G + c; if (L >= nwg) return false;
        int wgid = (int)L; { const int q = nwg / NXCD, r = nwg % NXCD, xcd = wgid % NXCD, off = wgid / NXCD; wgid = (xcd < r ? xcd * (q + 1) : r * (q + 1) + (xcd - r) * q) + off; }
        const int nig = WGM * nN, gid = wgid / nig, fm = gid * WGM, gsz = (nM - fm) < WGM ? (nM - fm) : WGM;
        const int rem = wgid % nig; u.pm = fm + (rem & (gsz - 1)); u.pn = rem >> (31 - __builtin_clz(gsz)); u.k0 = 0; u.nt = knt; return true;
    }
    __device__ __forceinline__ void a_ready(const Unit&) const {}
    __device__ __forceinline__ void done(const Unit&) const {}
};

__device__ __forceinline__ unsigned cvt_pk_bf16(float lo, float hi) { unsigned r; asm volatile("v_cvt_pk_bf16_f32 %0, %1, %2" : "=v"(r) : "v"(lo), "v"(hi)); return r; }
struct TailOrder {
    StaticOrder so; int nsplit, G, c;
    __host__ __device__ __forceinline__ void init(int G_, int c_, int K_) { so.init(16384, 1024, G_, c_, K_); nsplit = K_ / 256; G = G_; c = c_; }
    __host__ __device__ __forceinline__ bool next(int i, Unit& u) const {
        const long L = (long)i * G + c;
        if (L < 256) return so.next(i, u);
        const int j = (int)L - 256; if (j >= 16 * nsplit) return false;
        const int ks = j % nsplit, uu = j / nsplit; u.pm = 64 + (uu >> 2); u.pn = uu & 3; u.k0 = ks * 256; u.nt = 4; return true;
    }
    __device__ __forceinline__ void a_ready(const Unit&) const {}
    __device__ __forceinline__ void done(const Unit&) const {}
};

typedef unsigned u32x2 __attribute__((ext_vector_type(2)));
__device__ __forceinline__ float gelu_tanh_f(float x) { const float t = 1.5957691216057308f * (x + 0.044715f * x * x * x); return x * __builtin_amdgcn_rcpf(1.0f + __expf(-t)); }

struct EpiProj {
    static constexpr bool PERM = true, AFTER_DRAIN = false;
    bf16_t* O; int ldc;
    __device__ __forceinline__ void operator()(const f32x4 (&acc)[2][2][4][2], const Unit& u, int wr, int wc, int fr, int fq) const {
        const int row0 = u.pm * BM + wr * 64 + fr, col0 = u.pn * BM + wc * 32 + 8 * fq;
#pragma unroll
        for (int ai = 0; ai < 2; ++ai)
#pragma unroll
            for (int m = 0; m < 4; ++m) { bf16_t* rowp = O + (size_t)(row0 + ai * HALF + m * 16) * ldc + col0;
#pragma unroll
                for (int bj = 0; bj < 2; ++bj) { const f32x4 v0 = acc[ai][bj][m][0], v1 = acc[ai][bj][m][1];
                    u32x4 w; w.x = cvt_pk_bf16(v0[0], v0[1]); w.y = cvt_pk_bf16(v0[2], v0[3]); w.z = cvt_pk_bf16(v1[0], v1[1]); w.w = cvt_pk_bf16(v1[2], v1[3]);
                    *(u32x4*)(rowp + bj * HALF) = w; } }
    }
};
template <bool RESB, bool OUTB> struct EpiResidT {
    static constexpr bool PERM = false, AFTER_DRAIN = false;
    const float* resP; float* out; float alpha; float* part; int nsplit; const bf16_t* resB; bf16_t* outB;
    __device__ __forceinline__ void operator()(const f32x4 (&acc)[2][2][4][2], const Unit& u, int wr, int wc, int fr, int fq) const {
        const int col0 = u.pn * BM + wc * 32 + 4 * fq;
        if (u.pm >= 64) {
            float* pt = part + (size_t)((((u.pm - 64) * 4 + u.pn) * nsplit) + (u.k0 >> 8)) * 65536;
#pragma unroll
            for (int ai = 0; ai < 2; ++ai)
#pragma unroll
                for (int m = 0; m < 4; ++m) { const unsigned ro = (unsigned)(ai * HALF + wr * 64 + m * 16 + fr) * 256u + (unsigned)(wc * 32 + 4 * fq);
#pragma unroll
                    for (int bj = 0; bj < 2; ++bj)
#pragma unroll
                        for (int n = 0; n < 2; ++n) *(f32x4*)(pt + (ro + (unsigned)(bj * HALF + n * 16))) = acc[ai][bj][m][n]; }
            return;
        }
#pragma unroll
        for (int ai = 0; ai < 2; ++ai)
#pragma unroll
            for (int m = 0; m < 4; ++m) { const unsigned ro = (unsigned)(u.pm * BM + ai * HALF + wr * 64 + m * 16 + fr) * 1024u + (unsigned)col0;
#pragma unroll
                for (int bj = 0; bj < 2; ++bj)
#pragma unroll
                    for (int n = 0; n < 2; ++n) { const unsigned o = ro + (unsigned)(bj * HALF + n * 16); f32x4 x; if constexpr (RESB) { const u32x2 rw = *(const u32x2*)(resB + o); x = (f32x4){__uint_as_float(rw.x << 16), __uint_as_float(rw.x & 0xffff0000u), __uint_as_float(rw.y << 16), __uint_as_float(rw.y & 0xffff0000u)}; } else x = *(const f32x4*)(resP + o);
                        const f32x4 y = x * alpha + acc[ai][bj][m][n];
                        if constexpr (OUTB) { u32x2 w; w.x = cvt_pk_bf16(y[0], y[1]); w.y = cvt_pk_bf16(y[2], y[3]); *(u32x2*)(outB + o) = w; } else *(f32x4*)(out + o) = y; } }
    }
};
struct EpiFfn {
    static constexpr bool PERM = true, AFTER_DRAIN = false;
    bf16_t* H; float* GH; float* GF; const float* cw; const float* cb; const float* st; float* pf; float* sf;
    __device__ __forceinline__ void operator()(const f32x4 (&acc)[2][2][4][2], const Unit& u, int wr, int wc, int fr, int fq) const {
        const int lane = fresh_lane();
#pragma unroll
        for (int n = 0; n < 2; ++n) {
            const int col = u.pn * 128 + wc * 32 + 8 * fq + 4 * n;
            const f32x4 w0 = *(const f32x4*)(cw + col), w1 = *(const f32x4*)(cw + 2816 + col), w2 = *(const f32x4*)(cw + 5632 + col), bb = *(const f32x4*)(cb + col);
#pragma unroll
            for (int ai = 0; ai < 2; ++ai) {
                const int rbase = u.pm * BM + ai * HALF + wr * 64; const bool sample = rbase >= 16384; const int span = rbase >> 6;
                f32x4 prev = (f32x4){0.f, 0.f, 0.f, 0.f};
#pragma unroll
                for (int m = 0; m < 4; ++m) {
                    const int row = rbase + 16 * m + fr;
                    const f32x4 cur = acc[ai][0][m][n], val = acc[ai][1][m][n];
                    f32x4 g1, g2;
#pragma unroll
                    for (int e = 0; e < 4; ++e) {
                        const int pr1 = __builtin_amdgcn_update_dpp(0, __float_as_int(prev[e]), 0x121, 0xf, 0xf, false), pr2 = __builtin_amdgcn_update_dpp(0, __float_as_int(prev[e]), 0x122, 0xf, 0xf, false);
                        g1[e] = __int_as_float(__builtin_amdgcn_update_dpp(pr1, __float_as_int(cur[e]), 0x111, 0xf, 0xf, false));
                        g2[e] = __int_as_float(__builtin_amdgcn_update_dpp(pr2, __float_as_int(cur[e]), 0x112, 0xf, 0xf, false)); }
                    bool skip = false;
                    if (sample) {
                        const int t = row & 7, bidx = (row - 16384) >> 3;
                        if (t < 2) { const f32x4 sa = *(const f32x4*)(st + ((size_t)bidx * 2 + 0) * 2816 + col), sb = *(const f32x4*)(st + ((size_t)bidx * 2 + 1) * 2816 + col);
                            if (t == 0) { g1 = sb; g2 = sa; } else { g2 = sb; } }
                        if (t >= 6) *(f32x4*)(sf + ((size_t)bidx * 2 + (t - 6)) * 2816 + col) = cur;
                    } else {
                        if (m == 0 && fr < 2) { skip = true; *(f32x4*)(GF + (((size_t)span * 2 + fr) * 2 + 0) * 2816 + col) = cur; *(f32x4*)(GF + (((size_t)span * 2 + fr) * 2 + 1) * 2816 + col) = val; }
                        if (m == 3 && fr >= 14) { *(f32x4*)(GH + ((size_t)span * 2 + (fr - 14)) * 2816 + col) = cur;
                            if ((row & 2047) >= 2046) *(f32x4*)(pf + ((size_t)(row >> 11) * 2 + (fr - 14)) * 2816 + col) = cur; }
                    }
                    if (!skip) { u32x2 w;
                        const f32x4 x = g2 * w0 + g1 * w1 + cur * w2 + bb;
                        const f32x4 t = x * (x * x * (-0.044715f * 1.5957691216057308f) + (-1.5957691216057308f));
                        f32x4 r; r[0] = __builtin_amdgcn_rcpf(1.0f + __expf(t[0])); r[1] = __builtin_amdgcn_rcpf(1.0f + __expf(t[1])); r[2] = __builtin_amdgcn_rcpf(1.0f + __expf(t[2])); r[3] = __builtin_amdgcn_rcpf(1.0f + __expf(t[3]));
                        const f32x4 hv = x * r * val;
                        w.x = cvt_pk_bf16(hv[0], hv[1]); w.y = cvt_pk_bf16(hv[2], hv[3]); *(u32x2*)(H + (size_t)row * 2816 + col) = w; }
                    prev = cur;
                }
            }
        }
    }
};
template <class Epi, class Sched, bool ALIGN_EPI = false, bool SP2 = false>
__device__ __forceinline__ void gemm_phase(PG8_LAS unsigned char* lds, const Gemm g, const Sched& S, const Epi& E, const int wave_in) {
    int tid = wave_in * 64 + fresh_lane(); asm volatile("" : "+v"(tid));
    const int wid = wave_in, lane = tid & 63, wr = wid >> 2, wc = wid & 3, fr = lane & 15, fq = lane >> 4;
    const int K = g.K;
    unsigned voffA[2], voffB[2];
#pragma unroll
    for (int i = 0; i < 2; ++i) { int R, C; stage_rc(tid * 16 + i * 8192, R, C); const int Rb = Epi::PERM ? ((R & ~31) + perm32(R & 31)) : R;
        voffA[i] = (unsigned)(R * K + C) * 2u; voffB[i] = (unsigned)(Rb * K + C) * 2u; }
    const size_t kstep = (size_t)(BK * 2);
    const size_t hstep = (size_t)HALF * K * 2;
    const size_t tstep = 2 * hstep;
    const unsigned ldsw = (unsigned)wid * 1024u;
    const int aoff = lds_byte(wr * 64 + fr, fq * 8), boff = lds_byte(wc * 32 + fr, fq * 8);
#define PG8_SA(b, h) (((b) * 2 + (h)) * HTB)
#define PG8_SB(b, h) ((4 + (b) * 2 + (h)) * HTB)
#define PG8_STAGE(bufoff, gbase, voff) do { _Pragma("unroll") for (int _i = 0; _i < 2; ++_i) \
        __builtin_amdgcn_global_load_lds((const unsigned*)((const char*)(gbase) + (voff)[_i]), (PG8_LAS unsigned*)(lds + (bufoff) + ldsw + _i * 8192), 16, 0, 0); } while (0)
#define PG8_LDA(dst, b, h) do { _Pragma("unroll") for (int m = 0; m < 4; ++m) _Pragma("unroll") for (int k = 0; k < 2; ++k) dst[m][k] = *(const PG8_LAS bf16x8*)(lds + PG8_SA(b, h) + aoff + m * 2048 + k * 1024); } while (0)
#define PG8_LDB(dst, b, h) do { _Pragma("unroll") for (int n = 0; n < 2; ++n) _Pragma("unroll") for (int k = 0; k < 2; ++k) dst[n][k] = *(const PG8_LAS bf16x8*)(lds + PG8_SB(b, h) + boff + n * 2048 + k * 1024); } while (0)
#define PG8_MMA(ai, bj, At, Bt) do { __builtin_amdgcn_s_setprio(1); _Pragma("unroll") for (int m = 0; m < 4; ++m) _Pragma("unroll") for (int n = 0; n < 2; ++n) _Pragma("unroll") for (int k = 0; k < 2; ++k) \
        acc[ai][bj][m][n] = __builtin_amdgcn_mfma_f32_16x16x32_bf16(Bt[n][k], At[m][k], acc[ai][bj][m][n], 0, 0, 0); __builtin_amdgcn_s_setprio(0); } while (0)
#define PG8_WAIT_V(n) asm volatile("s_waitcnt vmcnt(" #n ")" ::: "memory")
#define PG8_WAIT_L(n) asm volatile("s_waitcnt lgkmcnt(" #n ")" ::: "memory")
#define PG8_BAR __builtin_amdgcn_s_barrier()
#define PG8_SCHED __builtin_amdgcn_sched_barrier(0)
    Unit cur, nxt; int ui = 0;
    if (!S.next(0, cur)) return;
    f32x4 acc[2][2][4][2];
#pragma unroll
    for (int a = 0; a < 2; ++a)
#pragma unroll
        for (int b = 0; b < 2; ++b)
#pragma unroll
            for (int m = 0; m < 4; ++m)
#pragma unroll
                for (int n = 0; n < 2; ++n) acc[a][b][m][n] = (f32x4){0.f, 0.f, 0.f, 0.f};
    bf16x8 At[4][2], B0[2][2], B1[2][2];
    const char* cA = (const char*)g.A + (size_t)cur.pm * tstep + (size_t)cur.k0 * 2; const char* cB = (const char*)g.Bt + (size_t)cur.pn * tstep + (size_t)cur.k0 * 2;
    S.a_ready(cur);
    if constexpr (SP2) {
        PG8_STAGE(PG8_SB(0, 0), cB, voffB); PG8_STAGE(PG8_SB(0, 1), cB + hstep, voffB); PG8_STAGE(PG8_SA(0, 0), cA, voffA); PG8_STAGE(PG8_SA(0, 1), cA + hstep, voffA);
        if (wr == 1) PG8_BAR;
        PG8_WAIT_V(2); PG8_BAR;
        PG8_STAGE(PG8_SB(1, 0), cB + kstep, voffB); PG8_STAGE(PG8_SA(1, 0), cA + kstep, voffA); PG8_STAGE(PG8_SB(1, 1), cB + hstep + kstep, voffB);
        PG8_WAIT_V(6); PG8_BAR;
    } else {
        PG8_STAGE(PG8_SB(0, 0), cB, voffB); PG8_STAGE(PG8_SA(0, 0), cA, voffA); PG8_STAGE(PG8_SB(0, 1), cB + hstep, voffB); PG8_STAGE(PG8_SA(0, 1), cA + hstep, voffA);
        if (wr == 1) PG8_BAR;
        PG8_WAIT_V(4); PG8_BAR;
        PG8_STAGE(PG8_SB(1, 0), cB + kstep, voffB); PG8_STAGE(PG8_SA(1, 0), cA + kstep, voffA); PG8_STAGE(PG8_SB(1, 1), cB + hstep + kstep, voffB);
        PG8_WAIT_V(6); PG8_BAR;
    }
    for (;;) {
        const bool has_next = S.next(ui + 1, nxt);
        const char* nA = has_next ? (const char*)g.A + (size_t)nxt.pm * tstep + (size_t)nxt.k0 * 2 : cA; const char* nB = has_next ? (const char*)g.Bt + (size_t)nxt.pn * tstep + (size_t)nxt.k0 * 2 : cB;
        const int nt = cur.nt;
        for (int t = 0; t < nt; t += 2) {
            const bool last = (t == nt - 2);
            const char* a1 = cA + (size_t)(t + 1) * kstep;
            const char* a2 = last ? nA : cA + (size_t)(t + 2) * kstep; const char* b2 = last ? nB : cB + (size_t)(t + 2) * kstep;
            const char* a3 = a2 + kstep; const char* b3 = b2 + kstep;
            if (last && has_next) S.a_ready(nxt);
            if constexpr (SP2) {
            PG8_LDB(B0, 0, 0); PG8_LDB(B1, 0, 1); PG8_SCHED; PG8_LDA(At, 0, 0); PG8_STAGE(PG8_SA(1, 1), a1 + hstep, voffA);
            PG8_WAIT_V(8); PG8_WAIT_L(0); PG8_BAR; PG8_MMA(0, 0, At, B0); PG8_MMA(0, 1, At, B1); PG8_BAR; PG8_SCHED;
            PG8_LDA(At, 0, 1); PG8_STAGE(PG8_SB(0, 0), b2, voffB); PG8_STAGE(PG8_SB(0, 1), b2 + hstep, voffB); PG8_STAGE(PG8_SA(0, 0), a2, voffA);
            PG8_WAIT_V(8); PG8_WAIT_L(0); PG8_BAR; PG8_MMA(1, 0, At, B0); PG8_MMA(1, 1, At, B1); PG8_BAR; PG8_SCHED;
            PG8_LDB(B0, 1, 0); PG8_LDB(B1, 1, 1); PG8_SCHED; PG8_LDA(At, 1, 0); PG8_STAGE(PG8_SA(0, 1), a2 + hstep, voffA);
            PG8_WAIT_V(8); PG8_WAIT_L(0); PG8_BAR; PG8_MMA(0, 0, At, B0); PG8_MMA(0, 1, At, B1); PG8_BAR; PG8_SCHED;
            PG8_LDA(At, 1, 1); PG8_STAGE(PG8_SB(1, 0), b3, voffB); PG8_STAGE(PG8_SB(1, 1), b3 + hstep, voffB); PG8_STAGE(PG8_SA(1, 0), a3, voffA);
            PG8_WAIT_V(8); PG8_WAIT_L(0); PG8_BAR; PG8_MMA(1, 0, At, B0); PG8_MMA(1, 1, At, B1); PG8_BAR; PG8_SCHED;
            } else {
            PG8_LDB(B0, 0, 0); PG8_SCHED; PG8_LDA(At, 0, 0); PG8_STAGE(PG8_SA(1, 1), a1 + hstep, voffA);
            PG8_WAIT_L(8); PG8_BAR; PG8_WAIT_L(0); PG8_MMA(0, 0, At, B0); PG8_BAR; PG8_SCHED;
            PG8_LDB(B1, 0, 1); PG8_STAGE(PG8_SB(0, 0), b2, voffB);
            PG8_BAR; PG8_WAIT_L(0); PG8_MMA(0, 1, At, B1); PG8_BAR;
            PG8_LDA(At, 0, 1); PG8_STAGE(PG8_SA(0, 0), a2, voffA);
            PG8_BAR; PG8_WAIT_L(0); PG8_MMA(1, 0, At, B0); PG8_BAR; PG8_SCHED;
            PG8_STAGE(PG8_SB(0, 1), b2 + hstep, voffB);
            PG8_WAIT_V(6); PG8_BAR; PG8_MMA(1, 1, At, B1); PG8_BAR;
            PG8_LDB(B0, 1, 0); PG8_SCHED; PG8_LDA(At, 1, 0); PG8_STAGE(PG8_SA(0, 1), a2 + hstep, voffA);
            PG8_WAIT_L(8); PG8_BAR; PG8_WAIT_L(0); PG8_MMA(0, 0, At, B0); PG8_BAR; PG8_SCHED;
            PG8_LDB(B1, 1, 1); PG8_STAGE(PG8_SB(1, 0), b3, voffB);
            PG8_BAR; PG8_WAIT_L(0); PG8_MMA(0, 1, At, B1); PG8_BAR;
            PG8_LDA(At, 1, 1); PG8_STAGE(PG8_SA(1, 0), a3, voffA);
            PG8_BAR; PG8_WAIT_L(0); PG8_MMA(1, 0, At, B0); PG8_BAR; PG8_SCHED;
            PG8_STAGE(PG8_SB(1, 1), b3 + hstep, voffB);
            PG8_WAIT_V(6); PG8_BAR; PG8_MMA(1, 1, At, B1); PG8_BAR;
            }
        }
        if constexpr (ALIGN_EPI) { if (wr == 0) PG8_BAR; }
        if constexpr (!Epi::AFTER_DRAIN) { E(acc, cur, wr, wc, fr, fq); S.done(cur); }
        if (!has_next) break;
#pragma unroll
        for (int a = 0; a < 2; ++a)
#pragma unroll
            for (int b = 0; b < 2; ++b)
#pragma unroll
                for (int m = 0; m < 4; ++m)
#pragma unroll
                    for (int n = 0; n < 2; ++n) acc[a][b][m][n] = (f32x4){0.f, 0.f, 0.f, 0.f};
        cur = nxt; cA = nA; cB = nB; ++ui;
        if constexpr (ALIGN_EPI) { if (wr == 1) PG8_BAR; }
    }
    PG8_WAIT_V(0);
    if constexpr (!ALIGN_EPI) { if (wr == 0) PG8_BAR; }
    PG8_BAR;
    if constexpr (Epi::AFTER_DRAIN) { E.fused(acc, cur, wr, wc, fr, fq, lds, wid, lane); S.done(cur); }
#undef PG8_SA
#undef PG8_SB
#undef PG8_STAGE
#undef PG8_LDA
#undef PG8_LDB
#undef PG8_MMA
#undef PG8_WAIT_V
#undef PG8_WAIT_L
#undef PG8_BAR
#undef PG8_SCHED
}
}
#define LAS __attribute__((address_space(3)))
typedef unsigned short bf16;
typedef short bf16x8 __attribute__((ext_vector_type(8)));
typedef float f32x4 __attribute__((ext_vector_type(4)));
typedef unsigned v4u __attribute__((ext_vector_type(4)));
typedef unsigned v2u __attribute__((ext_vector_type(2)));
constexpr int NWAVES = 8, NTHR = 512;
constexpr int MP = 16384, MS = 1024, M = MP + MS, D = 1024, NPROJ = 3328, DFF = 2816, NUP = 5632, T = 2048;
constexpr int C_QA = 0, C_KA = 384, C_VA = 768, C_ZA = 1152, C_XB = 1536, C_GB = 1792, C_QC = 2048, C_KC = 2240, C_VC = 2432, C_ZC = 2816, C_LC = 3200, C_BA = 3216, C_AA = 3222;
constexpr float ALPHA = 1.4142135623730951f;
constexpr float EPS = 1e-6f;
constexpr size_t O_Y = 0, O_PDCONV = (size_t)M * D, O_PDELTA = O_PDCONV + 2 * 8 * 3 * 1152, O_PLCONV = O_PDELTA + 2 * 8 * 6 * 4096, O_PLRU = O_PLCONV + 2 * 8 * 3 * 256,
    O_PGLA = O_PLRU + 2 * 8 * 256, O_PFCONV = O_PGLA + 2 * 8 * 6 * 2048, O_SDCONV = O_PFCONV + 2 * 8 * 2 * 2816, O_SDELTA = O_SDCONV + 2 * 128 * 3 * 1152,
    O_SLCONV = O_SDELTA + (size_t)2 * 128 * 6 * 4096, O_SLRU = O_SLCONV + 2 * 128 * 3 * 256, O_SGLA = O_SLRU + 2 * 128 * 256, O_SFCONV = O_SGLA + (size_t)2 * 128 * 6 * 2048,
    O_END = O_SFCONV + (size_t)2 * 128 * 2 * 2816;
constexpr size_t MiB = 1u << 20;
constexpr size_t WS_WIN = 1 * MiB, WS_WOUT = WS_WIN + (size_t)NPROJ * D * 2, WS_WUP = WS_WOUT + (size_t)D * D * 2, WS_WDN = WS_WUP + (size_t)NUP * D * 2;
constexpr size_t WS_XN = 26 * MiB;
constexpr size_t WS_R = 60 * MiB;
constexpr size_t WS_PROJ = WS_R;
constexpr size_t WS_DT = 171 * MiB;
constexpr size_t WS_GQ = 231 * MiB, WS_GU = 237 * MiB, WS_GD = 249 * MiB, WS_AB = 250 * MiB, WS_GAM = 251 * MiB;
constexpr size_t WS_H = WS_R, WS_GH = 154 * MiB, WS_GF = 160 * MiB, WS_PART = 210 * MiB, WS_YB1 = WS_R, WS_YB2 = 172 * MiB;
static_assert(WS_WDN + (size_t)D * DFF * 2 <= WS_XN && WS_XN + (size_t)M * D * 2 <= WS_R && WS_PROJ + (size_t)M * NPROJ * 2 <= WS_DT && WS_H + (size_t)M * DFF * 2 <= WS_GH, "ws map");
constexpr int LDS_BYTES = 147456;

__device__ __forceinline__ float bf2f(bf16 v) { return __uint_as_float((unsigned)v << 16); }
__device__ __forceinline__ unsigned f2bf(float f) { unsigned u = __float_as_uint(f); return (u + 0x7fffu + ((u >> 16) & 1u)) >> 16; }
__device__ __forceinline__ unsigned pk2(float lo, float hi) { return f2bf(lo) | (f2bf(hi) << 16); }
__device__ __forceinline__ float shidx(float v, int src) { return __int_as_float(__builtin_amdgcn_ds_bpermute(src << 2, __float_as_int(v))); }
__device__ __forceinline__ float shx(float v, int o, int lane) { return shidx(v, lane ^ o); }
__device__ __forceinline__ float wave_sum(float v, int lane) {
#pragma unroll
    for (int o = 1; o < 64; o <<= 1) v += shx(v, o, lane);
    return v;
}
__device__ __forceinline__ float sigm(float x) { return __builtin_amdgcn_rcpf(1.0f + __expf(-x)); }
__device__ __forceinline__ float siluf(float x) { return x * __builtin_amdgcn_rcpf(1.0f + __expf(-x)); }
__device__ __forceinline__ float softplusf(float x) { return x > 20.f ? x : log1pf(expf(x)); }
__device__ __forceinline__ float gelu_t(float x) { const float t = 1.5957691216057308f * (x + 0.044715f * x * x * x); return x * __builtin_amdgcn_rcpf(1.0f + __expf(-t)); }
__device__ __forceinline__ float rdlane(float v, int l) { return __int_as_float(__builtin_amdgcn_readlane(__float_as_int(v), l)); }
#define LDS_WAIT() asm volatile("s_waitcnt lgkmcnt(0)" ::: "memory")

template <int K> __device__ __forceinline__ f32x4 mma_lds(const LAS bf16* X1, int ld1, const LAS bf16* X2, int ld2, f32x4 acc, int lane) {
    const int r = lane & 15, q8 = (lane >> 4) * 8;
#pragma unroll
    for (int k0 = 0; k0 < K; k0 += 32) {
        const bf16x8 a = *(const LAS bf16x8*)(X1 + r * ld1 + k0 + q8);
        const bf16x8 b = *(const LAS bf16x8*)(X2 + r * ld2 + k0 + q8);
        acc = __builtin_amdgcn_mfma_f32_16x16x32_bf16(a, b, acc, 0, 0, 0);
    }
    return acc;
}

struct Args { const float* in[32]; float* out; unsigned char* ws; };
typedef const __attribute__((address_space(4))) Args CA;

__device__ __forceinline__ void transpose_item(const float* W, int K, int Nsrc, int mode, bf16* WT, LAS float* scr, int item, int nblk, int lane) {
    const int kb = item / nblk, nb = item % nblk, k0 = 64 * kb, n0 = 32 * nb;
    const int n = n0 + (lane & 31); int sc;
    if (mode == 0) sc = n;
    else if (mode == 1) sc = n < 1536 ? n : (n < 3216 ? n + 12 : (n < 3228 ? n - 1680 : -1));
    else { const int j = n & 255, pn = n >> 8; sc = j < 128 ? pn * 128 + j : 2816 + pn * 128 + (j - 128); }
#pragma unroll 8
    for (int i = 0; i < 32; ++i) { const int kk = 2 * i + (lane >> 5); scr[kk * 33 + (lane & 31)] = sc >= 0 ? W[(size_t)(k0 + kk) * Nsrc + sc] : 0.f; }
    LDS_WAIT();
    const int c = lane & 7;
#pragma unroll
    for (int j = 0; j < 4; ++j) { const int nn = (lane >> 3) + 8 * j; const LAS float* s = scr + (8 * c) * 33 + nn;
        v4u o; o.x = pk2(s[0 * 33], s[1 * 33]); o.y = pk2(s[2 * 33], s[3 * 33]); o.z = pk2(s[4 * 33], s[5 * 33]); o.w = pk2(s[6 * 33], s[7 * 33]);
        *(v4u*)(WT + (size_t)(n0 + nn) * K + k0 + 8 * c) = o; }
    LDS_WAIT();
}
__device__ __forceinline__ void convert_item(CA& A, LAS float* scr, int l, int it, int lane) {
    constexpr int I1 = 16 * 104, I2 = 16 * 32, I3 = 16 * 176;
    int r = it;
    if (r < I1) { transpose_item(A.in[8] + (size_t)l * D * 3228, D, 3228, 1, (bf16*)(A.ws + WS_WIN), scr, r, 104, lane); return; } r -= I1;
    if (r < I2) { transpose_item(A.in[23] + (size_t)l * D * D, D, D, 0, (bf16*)(A.ws + WS_WOUT), scr, r, 32, lane); return; } r -= I2;
    if (r < I3) { transpose_item(A.in[26] + (size_t)l * D * NUP, D, NUP, 2, (bf16*)(A.ws + WS_WUP), scr, r, 176, lane); return; } r -= I3;
    transpose_item(A.in[29] + (size_t)l * DFF * D, DFF, D, 0, (bf16*)(A.ws + WS_WDN), scr, r, 32, lane);
}
constexpr int CONV_IN = 16 * 104, CONV_A = 16 * 104 + 16 * 32 + 16 * 176, CONV_ALL = CONV_A + 44 * 32;
__device__ __forceinline__ void convert_weights(CA& A, LAS unsigned char* lds, int l, int first, int last, int gw, int NGW, int wave, int lane) {
    LAS float* scr = (LAS float*)(lds + wave * 16384);
    for (int it = first + gw; it < last; it += NGW) convert_item(A, scr, l, it, lane);
}
__device__ __forceinline__ void convert_weights_queue(CA& A, LAS unsigned char* lds, int l, unsigned* ctr, int wave, int lane) {
    LAS float* scr = (LAS float*)(lds + wave * 16384);
    for (;;) {
        unsigned it = 0u; if (lane == 0) it = __hip_atomic_fetch_add(ctr, 1u, __ATOMIC_RELAXED, __HIP_MEMORY_SCOPE_AGENT);
        it = (unsigned)__builtin_amdgcn_readfirstlane((int)it);
        if (it >= (unsigned)CONV_A) break;
        convert_item(A, scr, l, (int)it, lane);
    }
}
__device__ __forceinline__ void x_to_bf16(CA& A, int gw, int NGW, int lane) {
    bf16* XN = (bf16*)(A.ws + WS_XN);
    for (int m = gw; m < M; m += NGW) {
        const float* xr = m < MP ? A.in[0] + (size_t)m * D : A.in[1] + (size_t)(m - MP) * D;
        const f32x4* x4 = (const f32x4*)xr + lane; v2u* o = (v2u*)(XN + (size_t)m * D) + lane;
#pragma unroll
        for (int j = 0; j < 4; ++j) { const f32x4 v = x4[64 * j]; v2u w; w.x = pk2(v[0], v[1]); w.y = pk2(v[2], v[3]); o[64 * j] = w;
            if (m >= MP) ((f32x4*)(A.out + (size_t)m * D) + lane)[64 * j] = v * ALPHA; }
    }
}
template <int nsplit, bool INB> __device__ __forceinline__ void ln_load(CA& A, const float* part, const bf16* yb, int m, int lane, f32x4 (&v)[4]) {
    const f32x4* x4 = (const f32x4*)(A.out + (size_t)m * D) + lane;
    if (INB && m < MP) { const v2u* y2 = (const v2u*)(yb + (size_t)m * D) + lane;
#pragma unroll
        for (int j = 0; j < 4; ++j) { const v2u w = y2[64 * j]; v[j] = (f32x4){__uint_as_float(w.x << 16), __uint_as_float(w.x & 0xffff0000u), __uint_as_float(w.y << 16), __uint_as_float(w.y & 0xffff0000u)}; }
    } else {
#pragma unroll
        for (int j = 0; j < 4; ++j) v[j] = x4[64 * j]; }
    if (m >= MP) { const int pmq = (m - MP) >> 8, r = (m - MP) & 255;
#pragma unroll
        for (int j = 0; j < 4; ++j) { const float* pp = part + (size_t)((pmq * 4 + j) * nsplit) * 65536 + (size_t)r * 256 + 4 * lane;
            f32x4 pv[nsplit];
#pragma unroll
            for (int ks = 0; ks < nsplit; ++ks) pv[ks] = *(const f32x4*)(pp + (size_t)ks * 65536);
#pragma unroll
            for (int ks = 0; ks < nsplit; ++ks) v[j] = v[j] + pv[ks]; } }
}
template <bool WXN> __device__ __forceinline__ void ln_finish(CA& A, const float* g, const float* b, bool prescale, bool f32_prompt, int m, int lane, f32x4 (&v)[4]) {
    f32x4* x4 = (f32x4*)(A.out + (size_t)m * D) + lane; v2u* o = (v2u*)((bf16*)(A.ws + WS_XN) + (size_t)m * D) + lane;
    float s = 0.f;
#pragma unroll
    for (int j = 0; j < 4; ++j) s += (v[j][0] + v[j][1]) + (v[j][2] + v[j][3]);
    const float mean = wave_sum(s, lane) * (1.f / D); float s2 = 0.f;
#pragma unroll
    for (int j = 0; j < 4; ++j) { v[j] = v[j] - mean; s2 += (v[j][0] * v[j][0] + v[j][1] * v[j][1]) + (v[j][2] * v[j][2] + v[j][3] * v[j][3]); }
    const float rstd = 1.0f / sqrtf(wave_sum(s2, lane) * (1.f / D) + EPS);
#pragma unroll
    for (int j = 0; j < 4; ++j) { const f32x4 gg = *((const f32x4*)g + lane + 64 * j), bb = *((const f32x4*)b + lane + 64 * j);
        const f32x4 y = v[j] * rstd * gg + bb; if (f32_prompt || m >= MP) x4[64 * j] = (prescale && m >= MP) ? y * ALPHA : y;
        if constexpr (WXN) { v2u w; w.x = pk2(y[0], y[1]); w.y = pk2(y[2], y[3]); o[64 * j] = w; } }
}
template <int nsplit, bool INB, bool WXN> __device__ __forceinline__ void ln_pass(CA& A, const float* g, const float* b, bool prescale, bool f32_prompt, const float* part, const bf16* yb, int gw, int NGW, int lane) {
    for (int m = gw; m < M; m += 2 * NGW) {
        const int m2 = m + NGW; const bool two = m2 < M;
        f32x4 va[4], vb[4];
        ln_load<nsplit, INB>(A, part, yb, m, lane, va);
        if (two) ln_load<nsplit, INB>(A, part, yb, m2, lane, vb);
        ln_finish<WXN>(A, g, b, prescale, f32_prompt, m, lane, va);
        if (two) ln_finish<WXN>(A, g, b, prescale, f32_prompt, m2, lane, vb);
    }
}

__device__ __forceinline__ void sample_delta_item(CA& A, int l, int item, int lane) {
    const int h = item % 6, b = item / 6;
    const bf16* PROJ = (const bf16*)(A.ws + WS_PROJ); bf16* HEADS = (bf16*)(A.ws + WS_XN);
    const size_t row0 = (size_t)MP + b * 8;
    float S[64];
    const float* S0 = A.in[3] + (((size_t)l * 128 + b) * 6 + h) * 4096 + lane;
#pragma unroll
    for (int k = 0; k < 64; ++k) S[k] = S0[k * 64];
    const float* cs = A.in[2] + ((size_t)l * 128 + b) * 3 * 1152; const float* cwp = A.in[9] + (size_t)l * 4 * 1152;
    const int cq = h * 64 + lane, ck = 384 + cq, cv = 768 + cq;
    const float wq0 = cwp[cq], wq1 = cwp[1152 + cq], wq2 = cwp[2304 + cq], wq3 = cwp[3456 + cq];
    const float wk0 = cwp[ck], wk1 = cwp[1152 + ck], wk2 = cwp[2304 + ck], wk3 = cwp[3456 + ck];
    const float wv0 = cwp[cv], wv1 = cwp[1152 + cv], wv2 = cwp[2304 + cv], wv3 = cwp[3456 + cv];
    float q0 = cs[cq], q1 = cs[1152 + cq], q2 = cs[2304 + cq], k0 = cs[ck], k1 = cs[1152 + ck], k2 = cs[2304 + ck], v0 = cs[cv], v1 = cs[1152 + cv], v2 = cs[2304 + cv];
    const float ae = expf(A.in[10][l * 6 + h]), dtb = A.in[11][l * 6 + h], nw = A.in[12][l * 64 + lane];
#pragma unroll 1
    for (int t = 0; t < 8; ++t) {
        const size_t row = row0 + t; const bf16* pr = PROJ + row * NPROJ;
        const float pq = bf2f(pr[cq]), pk = bf2f(pr[ck]), pv = bf2f(pr[cv]);
        const float qv = siluf(q0 * wq0 + q1 * wq1 + q2 * wq2 + pq * wq3), kv = siluf(k0 * wk0 + k1 * wk1 + k2 * wk2 + pk * wk3), vv = siluf(v0 * wv0 + v1 * wv1 + v2 * wv2 + pv * wv3);
        q0 = q1; q1 = q2; q2 = pq; k0 = k1; k1 = k2; k2 = pk; v0 = v1; v1 = v2; v2 = pv;
        const float rq = rsqrtf(wave_sum(qv * qv, lane) + EPS) * 0.125f, rk = rsqrtf(wave_sum(kv * kv, lane) + EPS);
        const float qn = qv * rq, kn = kv * rk;
        const float beta = sigm(bf2f(pr[C_BA + h]));
        const float a = expf(-ae * softplusf(bf2f(pr[C_AA + h]) + dtb));
        float kS = 0.f;
#pragma unroll
        for (int k = 0; k < 64; ++k) kS += rdlane(kn, k) * S[k];
        const float dv = beta * (vv - a * kS);
        float o = 0.f;
#pragma unroll
        for (int k = 0; k < 64; ++k) { S[k] = a * S[k] + rdlane(kn, k) * dv; o += rdlane(qn, k) * S[k]; }
        const float rinv = rsqrtf(wave_sum(o * o, lane) * (1.f / 64.f) + EPS);
        const float z = bf2f(pr[C_ZA + h * 64 + lane]);
        HEADS[row * D + h * 64 + lane] = (bf16)f2bf(o * rinv * nw * siluf(z));
    }
    float* dc = A.out + O_SDCONV + ((size_t)l * 128 + b) * 3 * 1152;
    dc[cq] = q0; dc[1152 + cq] = q1; dc[2304 + cq] = q2; dc[ck] = k0; dc[1152 + ck] = k1; dc[2304 + ck] = k2; dc[cv] = v0; dc[1152 + cv] = v1; dc[2304 + cv] = v2;
    int lane2 = lane; asm volatile("" : "+v"(lane2));
    float* So = A.out + O_SDELTA + (((size_t)l * 128 + b) * 6 + h) * 4096 + lane2;
#pragma unroll
    for (int k = 0; k < 64; ++k) So[k * 64] = S[k];
}
__device__ __forceinline__ void sample_gla_item(CA& A, int l, int item, int lane) {
    const int h = item % 6, b = item / 6;
    const bf16* PROJ = (const bf16*)(A.ws + WS_PROJ); bf16* HEADS = (bf16*)(A.ws + WS_XN);
    const size_t row0 = (size_t)MP + b * 8;
    float S[32];
    const float* S0 = A.in[6] + (((size_t)l * 128 + b) * 6 + h) * 2048 + lane;
#pragma unroll
    for (int k = 0; k < 32; ++k) S[k] = S0[k * 64];
    const int kl = lane & 31;
    float w2[16];
#pragma unroll
    for (int r = 0; r < 16; ++r) w2[r] = A.in[20][((size_t)l * 16 + r) * 192 + h * 32 + kl];
    const float b2 = A.in[21][l * 192 + h * 32 + kl], nw = A.in[22][l * 64 + lane];
#pragma unroll 1
    for (int t = 0; t < 8; ++t) {
        const size_t row = row0 + t;
        float lg = b2;
#pragma unroll
        for (int r = 0; r < 16; ++r) lg += bf2f(PROJ[row * NPROJ + C_LC + r]) * w2[r];
        const float f = expf(-softplusf(-lg) * (1.f / 16.f));
        const float qk_ = bf2f(PROJ[row * NPROJ + C_QC + h * 32 + kl]) * 0.17677669529663687f, kk_ = bf2f(PROJ[row * NPROJ + C_KC + h * 32 + kl]);
        const float v = bf2f(PROJ[row * NPROJ + C_VC + h * 64 + lane]);
        float o = 0.f;
#pragma unroll
        for (int k = 0; k < 32; ++k) { S[k] = rdlane(f, k) * S[k] + rdlane(kk_, k) * v; o += rdlane(qk_, k) * S[k]; }
        const float rinv = rsqrtf(wave_sum(o * o, lane) * (1.f / 64.f) + EPS);
        const float z = bf2f(PROJ[row * NPROJ + C_ZC + h * 64 + lane]);
        HEADS[row * D + 640 + h * 64 + lane] = (bf16)f2bf(o * rinv * nw * siluf(z));
    }
    int lane2 = lane; asm volatile("" : "+v"(lane2));
    float* So = A.out + O_SGLA + (((size_t)l * 128 + b) * 6 + h) * 2048 + lane2;
#pragma unroll
    for (int k = 0; k < 32; ++k) So[k * 64] = S[k];
}

__device__ __forceinline__ void m1_delta_pair(CA& A, LAS unsigned char* lds, int l, int u, int tid, int lane, int wave) {
    constexpr int SUBB = 69632;
    const int item0 = 2 * u, bh = item0 >> 5, c0 = item0 & 31, b = bh / 6, h = bh % 6;
    const bf16* PROJ = (const bf16*)(A.ws + WS_PROJ);
    bf16* DT = (bf16*)(A.ws + WS_DT); constexpr size_t TS = (size_t)1536 * 4096;
    const float* cwp = A.in[9] + (size_t)l * 4 * 1152;
#pragma unroll
    for (int sub = 0; sub < 2; ++sub) {
        LAS float* Qf = (LAS float*)(lds + sub * SUBB); LAS float* Kf = Qf + 64 * 65; LAS float* Vf = Kf + 64 * 65;
        const int c = c0 + sub; const long row0 = (long)b * T + c * 64;
        const int ch = tid & 63, g = tid >> 6;
#pragma unroll
        for (int ten = 0; ten < 3; ++ten) {
            const int col = ten * 384 + h * 64 + ch;
            const float w0 = cwp[col], w1 = cwp[1152 + col], w2 = cwp[2304 + col], w3 = cwp[3456 + col];
            float x[11];
#pragma unroll
            for (int r = 0; r < 11; ++r) { const int i = 8 * g - 3 + r; x[r] = (c * 64 + i >= 0) ? bf2f(PROJ[(size_t)(row0 + i) * NPROJ + col]) : 0.f; }
            LAS float* dst = ten == 0 ? Qf : (ten == 1 ? Kf : Vf);
#pragma unroll
            for (int j = 0; j < 8; ++j) dst[(8 * g + j) * 65 + ch] = siluf(x[j] * w0 + x[j + 1] * w1 + x[j + 2] * w2 + x[j + 3] * w3);
        }
    }
    if (tid < 128) {
        const int sub = tid >> 6, i = tid & 63; LAS float* Gs = (LAS float*)(lds + sub * SUBB + 68352); LAS float* BETA = Gs + 64;
        const size_t pr = (size_t)((long)b * T + (c0 + sub) * 64 + i) * NPROJ;
        BETA[i] = sigm(bf2f(PROJ[pr + C_BA + h])); Gs[i] = -expf(A.in[10][l * 6 + h]) * softplusf(bf2f(PROJ[pr + C_AA + h]) + A.in[11][l * 6 + h]); }
    __syncthreads();
    if (wave < 2) { LAS float* Gs = (LAS float*)(lds + wave * SUBB + 68352); LAS float* GC = Gs + 128; float s = Gs[lane];
#pragma unroll
        for (int o = 1; o < 64; o <<= 1) { const float t = shidx(s, (lane - o) & 63); if (lane >= o) s += t; }
        GC[lane] = s; }
#pragma unroll
    for (int sub = 0; sub < 2; ++sub) {
        LAS float* Qf = (LAS float*)(lds + sub * SUBB); LAS float* Kf = Qf + 64 * 65;
        LAS bf16* Kb = (LAS bf16*)(lds + sub * SUBB + 49920); LAS bf16* Qb = Kb + 64 * 72;
        LAS float* Gs = (LAS float*)(lds + sub * SUBB + 68352); LAS float* BETA = Gs + 64; LAS float* RQ = Gs + 192; LAS float* RK = Gs + 256;
        const long row0 = (long)b * T + (c0 + sub) * 64;
        const int i = tid >> 3, p = tid & 7; float q[8], k[8], sq = 0.f, sk = 0.f;
#pragma unroll
        for (int d = 0; d < 8; ++d) { q[d] = Qf[i * 65 + 8 * p + d]; k[d] = Kf[i * 65 + 8 * p + d]; sq += q[d] * q[d]; sk += k[d] * k[d]; }
        sq += shx(sq, 1, lane); sq += shx(sq, 2, lane); sq += shx(sq, 4, lane);
        sk += shx(sk, 1, lane); sk += shx(sk, 2, lane); sk += shx(sk, 4, lane);
        const float rq = rsqrtf(sq + EPS) * 0.125f, rk = rsqrtf(sk + EPS);
        v4u wq, wk; wq.x = pk2(q[0] * rq, q[1] * rq); wq.y = pk2(q[2] * rq, q[3] * rq); wq.z = pk2(q[4] * rq, q[5] * rq); wq.w = pk2(q[6] * rq, q[7] * rq);
        wk.x = pk2(k[0] * rk, k[1] * rk); wk.y = pk2(k[2] * rk, k[3] * rk); wk.z = pk2(k[4] * rk, k[5] * rk); wk.w = pk2(k[6] * rk, k[7] * rk);
        *(LAS v4u*)(Qb + i * 72 + 8 * p) = wq; *(LAS v4u*)(Kb + i * 72 + 8 * p) = wk;
        if (p == 0) { RQ[i] = rq; RK[i] = rk; }
    }
    __syncthreads();
    f32x4 Lt_[4];
#pragma unroll
    for (int s = 0; s < 8; ++s) {
        const int t = wave + 8 * s, sub = t >> 5, kind = (t >> 4) & 1, at = (t >> 2) & 3, bt = t & 3;
        LAS bf16* Kb = (LAS bf16*)(lds + sub * SUBB + 49920); LAS bf16* Qb = Kb + 64 * 72;
        LAS float* Gs = (LAS float*)(lds + sub * SUBB + 68352); LAS float* BETA = Gs + 64; LAS float* GC = Gs + 128;
        const int i = 16 * bt + (lane & 15), j0 = 16 * at + 4 * (lane >> 4);
        f32x4 acc = (f32x4){0.f, 0.f, 0.f, 0.f};
        if (at <= bt) acc = mma_lds<64>(Kb + at * 16 * 72, 72, (kind ? Qb : Kb) + bt * 16 * 72, 72, acc, lane);
        const float gi = GC[i];
        if (kind == 0) { const float bi = BETA[i]; f32x4 o;
#pragma unroll
            for (int e = 0; e < 4; ++e) { const int j = j0 + e; o[e] = (j < i) ? bi * acc[e] * __expf(gi - GC[j]) : 0.f; }
            Lt_[(s & 1) + 2 * (s >> 2)] = o;
        } else { float o[4];
#pragma unroll
            for (int e = 0; e < 4; ++e) { const int j = j0 + e; o[e] = (j <= i) ? acc[e] * __expf(gi - GC[j]) : 0.f; }
            v2u w; w.x = pk2(o[0], o[1]); w.y = pk2(o[2], o[3]); *(v2u*)(DT + 2 * TS + (size_t)(item0 + sub) * 4096 + i * 64 + j0) = w; }
    }
    __syncthreads();
#pragma unroll
    for (int s = 0; s < 8; ++s) {
        const int t = wave + 8 * s, sub = t >> 5, kind = (t >> 4) & 1, at = (t >> 2) & 3, bt = t & 3;
        if (kind == 0) { LAS float* Lm = (LAS float*)(lds + sub * SUBB + 49920); const int i = 16 * bt + (lane & 15), j0 = 16 * at + 4 * (lane >> 4);
            *(LAS f32x4*)(Lm + i * 68 + j0) = Lt_[(s & 1) + 2 * (s >> 2)]; }
    }
    __syncthreads();
    if (wave < 4) {
        const int sub = wave >> 1, cidx = tid & 127, item = item0 + sub;
        LAS float* Qf = (LAS float*)(lds + sub * SUBB); LAS float* Kf = Qf + 64 * 65; LAS float* Vf = Kf + 64 * 65;
        LAS float* Lm = (LAS float*)(lds + sub * SUBB + 49920);
        LAS float* Gs = (LAS float*)(lds + sub * SUBB + 68352); LAS float* BETA = Gs + 64; LAS float* GC = Gs + 128; LAS float* RK = Gs + 256;
        bf16* gWK = DT + (size_t)item * 4096; bf16* gUT = gWK + 4 * TS;
        float x[64];
        if (cidx < 64) {
#pragma unroll
            for (int i = 0; i < 64; ++i) x[i] = BETA[i] * Vf[i * 65 + cidx];
        } else { const int kc = cidx - 64;
#pragma unroll
            for (int i = 0; i < 64; ++i) x[i] = BETA[i] * __expf(GC[i]) * RK[i] * Kf[i * 65 + kc]; }
#pragma unroll
        for (int i = 1; i < 64; ++i) { float s0 = 0.f, s1 = 0.f, s2 = 0.f, s3 = 0.f;
#pragma unroll
            for (int j4 = 0; j4 < (i + 3) / 4; ++j4) { const f32x4 Lv = *(const LAS f32x4*)(Lm + i * 68 + 4 * j4);
                s0 += Lv[0] * x[4 * j4]; s1 += Lv[1] * x[4 * j4 + 1]; s2 += Lv[2] * x[4 * j4 + 2]; s3 += Lv[3] * x[4 * j4 + 3]; }
            x[i] -= (s0 + s1) + (s2 + s3); }
        if (cidx < 64) {
#pragma unroll
            for (int j8 = 0; j8 < 8; ++j8) { v4u w; w.x = pk2(x[8 * j8], x[8 * j8 + 1]); w.y = pk2(x[8 * j8 + 2], x[8 * j8 + 3]); w.z = pk2(x[8 * j8 + 4], x[8 * j8 + 5]); w.w = pk2(x[8 * j8 + 6], x[8 * j8 + 7]);
                *(v4u*)(gUT + cidx * 64 + 8 * j8) = w; }
        } else { const int kc = cidx - 64;
#pragma unroll
            for (int j = 0; j < 64; ++j) gWK[j * 64 + kc] = (bf16)f2bf(x[j]); }
        if (cidx == 0) ((float*)(A.ws + WS_GAM))[item] = __expf(GC[63]);
    } else {
        for (int uu_ = tid - 256; uu_ < 2048; uu_ += 256) {
            const int sub = uu_ >> 10, u2 = uu_ & 1023, item = item0 + sub;
            LAS float* Qf = (LAS float*)(lds + sub * SUBB); LAS float* Kf = Qf + 64 * 65;
            LAS float* Gs = (LAS float*)(lds + sub * SUBB + 68352); LAS float* GC = Gs + 128; LAS float* RQ = Gs + 192; LAS float* RK = Gs + 256;
            bf16* gQT = DT + TS + (size_t)item * 4096; bf16* gKDT = DT + 3 * TS + (size_t)item * 4096;
            const float gl = GC[63];
            if (u2 < 512) { const int i = u2 >> 3, k8 = (u2 & 7) * 8; const float sc = RQ[i] * __expf(GC[i]); float q[8];
#pragma unroll
                for (int d = 0; d < 8; ++d) q[d] = Qf[i * 65 + k8 + d] * sc;
                v4u w; w.x = pk2(q[0], q[1]); w.y = pk2(q[2], q[3]); w.z = pk2(q[4], q[5]); w.w = pk2(q[6], q[7]); *(v4u*)(gQT + i * 64 + k8) = w;
            } else { const int uu = u2 - 512, k = uu >> 3, j8 = (uu & 7) * 8; float q[8];
#pragma unroll
                for (int d = 0; d < 8; ++d) { const int j = j8 + d; q[d] = Kf[j * 65 + k] * RK[j] * __expf(gl - GC[j]); }
                v4u w; w.x = pk2(q[0], q[1]); w.y = pk2(q[2], q[3]); w.z = pk2(q[4], q[5]); w.w = pk2(q[6], q[7]); *(v4u*)(gKDT + k * 64 + j8) = w; }
        }
        if (c0 == 30 && tid >= 256 && tid < 448) { const int t2 = tid - 256, ten = t2 >> 6, col = ten * 384 + h * 64 + (t2 & 63); const long rl = (long)b * T + 2045;
#pragma unroll
            for (int r = 0; r < 3; ++r) A.out[O_PDCONV + (((size_t)l * 8 + b) * 3 + r) * 1152 + col] = bf2f(PROJ[(size_t)(rl + r) * NPROJ + col]); }
    }
    __syncthreads();
}

__device__ __forceinline__ void m1_gla_pair(CA& A, LAS unsigned char* lds, int l, int u, int tid, int lane, int wave) {
    constexpr int SUBB = 46080;
    const int item0 = 2 * u, bh = item0 >> 5, c0 = item0 & 31, b = bh / 6, h = bh % 6;
    const bf16* PROJ = (const bf16*)(A.ws + WS_PROJ); bf16* HEADS = (bf16*)(A.ws + WS_XN);
    const int i = tid >> 3, p = tid & 7;
    f32x4 w2v[16];
#pragma unroll
    for (int r = 0; r < 16; ++r) w2v[r] = *(const f32x4*)(A.in[20] + ((size_t)l * 16 + r) * 192 + h * 32 + 4 * p);
    const f32x4 b2v = *(const f32x4*)(A.in[21] + l * 192 + h * 32 + 4 * p);
#pragma unroll
    for (int sub = 0; sub < 2; ++sub) {
        LAS float* BC = (LAS float*)(lds + sub * SUBB + 2304);
        const size_t pr = ((size_t)b * T + (c0 + sub) * 64 + i) * NPROJ;
        float lc[16];
        const v4u l0 = *(const v4u*)(PROJ + pr + C_LC), l1 = *(const v4u*)(PROJ + pr + C_LC + 8);
        const unsigned lw[8] = {l0.x, l0.y, l0.z, l0.w, l1.x, l1.y, l1.z, l1.w};
#pragma unroll
        for (int r = 0; r < 8; ++r) { lc[2 * r] = __uint_as_float(lw[r] << 16); lc[2 * r + 1] = __uint_as_float(lw[r] & 0xffff0000u); }
#pragma unroll
        for (int d = 0; d < 4; ++d) { const int k = 4 * p + d; float lg = b2v[d];
#pragma unroll
            for (int r = 0; r < 16; ++r) lg += lc[r] * w2v[r][d];
            BC[i * 33 + k] = -softplusf(-lg) * (1.f / 16.f); }
    }
    __syncthreads();
    { const int k = tid & 31, sg = tid >> 5;
#pragma unroll
      for (int sub = 0; sub < 2; ++sub) { LAS float* BC = (LAS float*)(lds + sub * SUBB + 2304); LAS float* SEG = (LAS float*)(lds + sub * SUBB + 44032);
          SEG[sg * 32 + k] = (BC[(4 * sg) * 33 + k] + BC[(4 * sg + 1) * 33 + k]) + (BC[(4 * sg + 2) * 33 + k] + BC[(4 * sg + 3) * 33 + k]); } }
    __syncthreads();
#pragma unroll
    for (int sub = 0; sub < 2; ++sub) {
        const int item = item0 + sub;
        bf16* gQ = (bf16*)(A.ws + WS_GQ) + (size_t)item * 2048; float* gD = (float*)(A.ws + WS_GD) + (size_t)item * 32;
        LAS float* BC = (LAS float*)(lds + sub * SUBB + 2304); LAS float* SEG = (LAS float*)(lds + sub * SUBB + 44032);
        LAS bf16* Qb = (LAS bf16*)(lds + sub * SUBB + 10752); LAS bf16* Kb = (LAS bf16*)(lds + sub * SUBB + 15872); LAS bf16* KDt = (LAS bf16*)(lds + sub * SUBB + 20992); LAS bf16* Vt = (LAS bf16*)(lds + sub * SUBB + 25600);
        const size_t pr = ((size_t)b * T + (c0 + sub) * 64 + i) * NPROJ;
        const v2u qw = *(const v2u*)(PROJ + pr + C_QC + h * 32 + 4 * p), kw = *(const v2u*)(PROJ + pr + C_KC + h * 32 + 4 * p);
        const float qv[4] = {__uint_as_float(qw.x << 16), __uint_as_float(qw.x & 0xffff0000u), __uint_as_float(qw.y << 16), __uint_as_float(qw.y & 0xffff0000u)};
        const float kv[4] = {__uint_as_float(kw.x << 16), __uint_as_float(kw.x & 0xffff0000u), __uint_as_float(kw.y << 16), __uint_as_float(kw.y & 0xffff0000u)};
        float qt[4], kt[4];
#pragma unroll
        for (int d = 0; d < 4; ++d) { const int k = 4 * p + d; float bb = 0.f, bl = 0.f;
#pragma unroll
            for (int q = 0; q < 16; ++q) { const float sq = SEG[q * 32 + k]; bl += sq; if (q < (i >> 2)) bb += sq; }
#pragma unroll
            for (int q = 0; q < 4; ++q) { const float f = BC[(4 * (i >> 2) + q) * 33 + k]; if (q <= (i & 3)) bb += f; }
            qt[d] = qv[d] * 0.17677669529663687f * __expf(bb); kt[d] = kv[d] * __expf(-bb); KDt[k * 72 + i] = (bf16)f2bf(kv[d] * __expf(bl - bb)); }
        v2u w; w.x = pk2(qt[0], qt[1]); w.y = pk2(qt[2], qt[3]); *(LAS v2u*)(Qb + i * 40 + 4 * p) = w; *(v2u*)(gQ + i * 32 + 4 * p) = w;
        w.x = pk2(kt[0], kt[1]); w.y = pk2(kt[2], kt[3]); *(LAS v2u*)(Kb + i * 40 + 4 * p) = w;
        const v4u vw = *(const v4u*)(PROJ + pr + C_VC + h * 64 + 8 * p); const unsigned vws[4] = {vw.x, vw.y, vw.z, vw.w};
#pragma unroll
        for (int d = 0; d < 4; ++d) { Vt[(8 * p + 2 * d) * 72 + i] = (bf16)(vws[d] & 0xffffu); Vt[(8 * p + 2 * d + 1) * 72 + i] = (bf16)(vws[d] >> 16); }
        if (tid < 32) { float tl = 0.f;
#pragma unroll
            for (int q = 0; q < 16; ++q) tl += SEG[q * 32 + tid];
            gD[tid] = __expf(tl); }
    }
    __syncthreads();
#pragma unroll
    for (int s = 0; s < 4; ++s) {
        const int t = 4 * wave + s, sub = t >> 4, at = (t >> 2) & 3, bt = t & 3; const int ii = 16 * bt + (lane & 15), j0 = 16 * at + 4 * (lane >> 4);
        LAS bf16* Qb = (LAS bf16*)(lds + sub * SUBB + 10752); LAS bf16* Kb = (LAS bf16*)(lds + sub * SUBB + 15872); LAS bf16* ATb = (LAS bf16*)(lds + sub * SUBB + 34816);
        f32x4 acc = (f32x4){0.f, 0.f, 0.f, 0.f};
        if (at <= bt) acc = mma_lds<32>(Kb + at * 16 * 40, 40, Qb + bt * 16 * 40, 40, acc, lane);
        float o[4];
#pragma unroll
        for (int e = 0; e < 4; ++e) o[e] = (j0 + e <= ii) ? acc[e] : 0.f;
        v2u w; w.x = pk2(o[0], o[1]); w.y = pk2(o[2], o[3]); *(LAS v2u*)(ATb + ii * 72 + j0) = w;
    }
    __syncthreads();
#pragma unroll
    for (int s = 0; s < 4; ++s) {
        const int t = 4 * wave + s, sub = t >> 4, at = (t >> 2) & 3, bt = t & 3; const int ii = 16 * bt + (lane & 15), v0 = 16 * at + 4 * (lane >> 4);
        LAS bf16* Vt = (LAS bf16*)(lds + sub * SUBB + 25600); LAS bf16* ATb = (LAS bf16*)(lds + sub * SUBB + 34816);
        f32x4 acc = (f32x4){0.f, 0.f, 0.f, 0.f};
        acc = mma_lds<64>(Vt + at * 16 * 72, 72, ATb + bt * 16 * 72, 72, acc, lane);
        v2u w; w.x = pk2(acc[0], acc[1]); w.y = pk2(acc[2], acc[3]); *(v2u*)(HEADS + ((size_t)b * T + (c0 + sub) * 64 + ii) * D + 640 + h * 64 + v0) = w;
    }
#pragma unroll
    for (int s = 0; s < 2; ++s) {
        const int t = 2 * wave + s, sub = t >> 3, at = (t >> 2) & 1, bt = t & 3; const int v = 16 * bt + (lane & 15), k0 = 16 * at + 4 * (lane >> 4);
        LAS bf16* KDt = (LAS bf16*)(lds + sub * SUBB + 20992); LAS bf16* Vt = (LAS bf16*)(lds + sub * SUBB + 25600);
        float* gU = (float*)(A.ws + WS_GU) + (size_t)(item0 + sub) * 2048;
        f32x4 acc = (f32x4){0.f, 0.f, 0.f, 0.f};
        acc = mma_lds<64>(KDt + at * 16 * 72, 72, Vt + bt * 16 * 72, 72, acc, lane);
        *(f32x4*)(gU + v * 32 + k0) = acc;
    }
    __syncthreads();
}

__device__ __forceinline__ void m2_delta(CA& A, LAS unsigned char* lds, int l, int bh, int tid, int lane, int wave) {
    const int b = bh / 6, h = bh % 6;
    const bf16* PROJ = (const bf16*)(A.ws + WS_PROJ); bf16* HEADS = (bf16*)(A.ws + WS_XN);
    const bf16* DT = (const bf16*)(A.ws + WS_DT); constexpr size_t TS = (size_t)1536 * 4096; const float* GAM = (const float*)(A.ws + WS_GAM);
    LAS bf16* St = (LAS bf16*)lds;
    LAS bf16* Wt = St + 2 * 4608;
    LAS bf16* TB = Wt + 4608;
    const int lrow = tid >> 3, lc8 = (tid & 7) * 8;
    for (int u = tid; u < 4608 / 2; u += NTHR) ((LAS unsigned*)St)[u] = 0u;
    f32x4 Sreg[4];
#pragma unroll
    for (int kt = 0; kt < 4; ++kt) Sreg[kt] = (f32x4){0.f, 0.f, 0.f, 0.f};
    v4u nx[5];
    { const bf16* src = DT + (size_t)(bh * 32) * 4096 + lrow * 64 + lc8;
#pragma unroll
      for (int q = 0; q < 5; ++q) nx[q] = *(const v4u*)(src + q * TS);
#pragma unroll
      for (int q = 0; q < 5; ++q) *(LAS v4u*)(TB + q * 4608 + lrow * 72 + lc8) = nx[q]; }
    __syncthreads();
    for (int c = 0; c < 32; ++c) {
        const int cur = c & 1, item = bh * 32 + c;
        LAS bf16* Sc = St + cur * 4608; LAS bf16* Sn = St + (cur ^ 1) * 4608;
        LAS bf16* tWK = TB + cur * 5 * 4608; LAS bf16* tQT = tWK + 4608; LAS bf16* tATT = tQT + 4608; LAS bf16* tKDT = tATT + 4608; LAS bf16* tUT = tKDT + 4608;
        if (c + 1 < 32) { const bf16* src = DT + (size_t)(item + 1) * 4096 + lrow * 64 + lc8;
#pragma unroll
            for (int q = 0; q < 5; ++q) nx[q] = *(const v4u*)(src + q * TS); }
        const float gam = GAM[item];
        v2u zpre[4];
        if (wave < 4) { const size_t rowz = (size_t)b * T + c * 64 + 16 * wave + (lane & 15);
#pragma unroll
            for (int vt = 0; vt < 4; ++vt) zpre[vt] = *(const v2u*)(PROJ + rowz * NPROJ + C_ZA + h * 64 + 16 * vt + 4 * (lane >> 4)); }
#pragma unroll
        for (int s = 0; s < 2; ++s) {
            const int t = 2 * wave + s, jt = t & 3, vt = t >> 2;
            f32x4 acc = (f32x4){0.f, 0.f, 0.f, 0.f};
            acc = mma_lds<64>(tWK + jt * 16 * 72, 72, Sc + vt * 16 * 72, 72, acc, lane);
            const int v = 16 * vt + (lane & 15), j0 = 16 * jt + 4 * (lane >> 4);
            const v2u uw = *(const LAS v2u*)(tUT + v * 72 + j0);
            const float w0 = __uint_as_float(uw.x << 16) - acc[0], w1 = __uint_as_float(uw.x & 0xffff0000u) - acc[1], w2 = __uint_as_float(uw.y << 16) - acc[2], w3 = __uint_as_float(uw.y & 0xffff0000u) - acc[3];
            v2u w; w.x = pk2(w0, w1); w.y = pk2(w2, w3); *(LAS v2u*)(Wt + v * 72 + j0) = w;
        }
        __syncthreads();
        if (wave < 4) {
            const int it = wave; f32x4 o[4]; float ss = 0.f;
#pragma unroll
            for (int vt = 0; vt < 4; ++vt) { o[vt] = (f32x4){0.f, 0.f, 0.f, 0.f};
                o[vt] = mma_lds<64>(Sc + vt * 16 * 72, 72, tQT + it * 16 * 72, 72, o[vt], lane);
                o[vt] = mma_lds<64>(Wt + vt * 16 * 72, 72, tATT + it * 16 * 72, 72, o[vt], lane);
                ss += (o[vt][0] * o[vt][0] + o[vt][1] * o[vt][1]) + (o[vt][2] * o[vt][2] + o[vt][3] * o[vt][3]); }
            ss += shx(ss, 16, lane); ss += shx(ss, 32, lane);
            const float rinv = rsqrtf(ss * (1.f / 64.f) + EPS);
            const size_t row = (size_t)b * T + c * 64 + 16 * it + (lane & 15);
#pragma unroll
            for (int vt = 0; vt < 4; ++vt) { const int v0 = 16 * vt + 4 * (lane >> 4);
                const v2u zw = zpre[vt]; const f32x4 nw = *(const f32x4*)(A.in[12] + l * 64 + v0);
                const float z0 = __uint_as_float(zw.x << 16), z1 = __uint_as_float(zw.x & 0xffff0000u), z2 = __uint_as_float(zw.y << 16), z3 = __uint_as_float(zw.y & 0xffff0000u);
                v2u w; w.x = pk2(o[vt][0] * rinv * nw[0] * siluf(z0), o[vt][1] * rinv * nw[1] * siluf(z1)); w.y = pk2(o[vt][2] * rinv * nw[2] * siluf(z2), o[vt][3] * rinv * nw[3] * siluf(z3));
                *(v2u*)(HEADS + row * D + h * 64 + v0) = w; }
        } else {
            const int vt = wave - 4, v = 16 * vt + (lane & 15);
#pragma unroll
            for (int kt = 0; kt < 4; ++kt) { Sreg[kt] = Sreg[kt] * gam;
                Sreg[kt] = mma_lds<64>(tKDT + kt * 16 * 72, 72, Wt + vt * 16 * 72, 72, Sreg[kt], lane);
                v2u w; w.x = pk2(Sreg[kt][0], Sreg[kt][1]); w.y = pk2(Sreg[kt][2], Sreg[kt][3]); *(LAS v2u*)(Sn + v * 72 + 16 * kt + 4 * (lane >> 4)) = w; }
        }
        if (c + 1 < 32) { LAS bf16* dst = TB + (cur ^ 1) * 5 * 4608 + lrow * 72 + lc8;
#pragma unroll
            for (int q = 0; q < 5; ++q) *(LAS v4u*)(dst + q * 4608) = nx[q]; }
        __syncthreads();
    }
    if (wave >= 4) { const int vt = wave - 4, v = 16 * vt + (lane & 15); float* So = A.out + O_PDELTA + (((size_t)l * 8 + b) * 6 + h) * 4096;
#pragma unroll
        for (int kt = 0; kt < 4; ++kt)
#pragma unroll
            for (int e = 0; e < 4; ++e) So[(16 * kt + 4 * (lane >> 4) + e) * 64 + v] = Sreg[kt][e]; }
    __syncthreads();
}
__device__ __forceinline__ void m2_gla(CA& A, LAS unsigned char* lds, int l, int bh, int tid, int lane, int wave) {
    const int b = bh / 6, h = bh % 6;
    const bf16* PROJ = (const bf16*)(A.ws + WS_PROJ); bf16* HEADS = (bf16*)(A.ws + WS_XN);
    const bf16* gQ = (const bf16*)(A.ws + WS_GQ) + (size_t)bh * 32 * 2048; const float* gU = (const float*)(A.ws + WS_GU) + (size_t)bh * 32 * 2048; const float* gD = (const float*)(A.ws + WS_GD) + (size_t)bh * 32 * 32;
    LAS bf16* SbB = (LAS bf16*)lds;
    LAS bf16* QbB = SbB + 2 * 64 * 40;
    const int v = tid >> 3, k4 = (tid & 7) * 4;
    f32x4 S = (f32x4){0.f, 0.f, 0.f, 0.f};
    v4u qn = (v4u){0u, 0u, 0u, 0u}; f32x4 un, dn;
    if (tid < 256) qn = *(const v4u*)(gQ + tid * 8);
    un = *(const f32x4*)(gU + v * 32 + k4); dn = *(const f32x4*)(gD + k4);
    const f32x4 nw0 = *(const f32x4*)(A.in[22] + l * 64 + 4 * (lane >> 4)), nw1 = *(const f32x4*)(A.in[22] + l * 64 + 16 + 4 * (lane >> 4)), nw2 = *(const f32x4*)(A.in[22] + l * 64 + 32 + 4 * (lane >> 4)), nw3 = *(const f32x4*)(A.in[22] + l * 64 + 48 + 4 * (lane >> 4));
    v2u on[4], zn[4];
    if (wave < 4) { const size_t row = (size_t)b * T + 16 * wave + (lane & 15);
#pragma unroll
        for (int vt = 0; vt < 4; ++vt) { const int v0 = 16 * vt + 4 * (lane >> 4); on[vt] = *(const v2u*)(HEADS + row * D + 640 + h * 64 + v0); zn[vt] = *(const v2u*)(PROJ + row * NPROJ + C_ZC + h * 64 + v0); } }
    for (int c = 0; c < 32; ++c) {
        const int cur = c & 1; LAS bf16* Sb = SbB + cur * 64 * 40; LAS bf16* Qb = QbB + cur * 64 * 40;
        const v4u qc = qn; const f32x4 uc = un, dc = dn;
        v2u oc[4], zc[4];
#pragma unroll
        for (int vt = 0; vt < 4; ++vt) { oc[vt] = on[vt]; zc[vt] = zn[vt]; }
        if (c + 1 < 32) { if (tid < 256) qn = *(const v4u*)(gQ + (size_t)(c + 1) * 2048 + tid * 8); un = *(const f32x4*)(gU + (size_t)(c + 1) * 2048 + v * 32 + k4); dn = *(const f32x4*)(gD + (c + 1) * 32 + k4);
            if (wave < 4) { const size_t row = (size_t)b * T + (c + 1) * 64 + 16 * wave + (lane & 15);
#pragma unroll
                for (int vt = 0; vt < 4; ++vt) { const int v0 = 16 * vt + 4 * (lane >> 4); on[vt] = *(const v2u*)(HEADS + row * D + 640 + h * 64 + v0); zn[vt] = *(const v2u*)(PROJ + row * NPROJ + C_ZC + h * 64 + v0); } } }
        { v2u w; w.x = pk2(S[0], S[1]); w.y = pk2(S[2], S[3]); *(LAS v2u*)(Sb + v * 40 + k4) = w; }
        if (tid < 256) *(LAS v4u*)(Qb + (tid >> 2) * 40 + (tid & 3) * 8) = qc;
        __syncthreads();
        if (wave < 4) {
            const int it = wave; f32x4 o[4]; float ss = 0.f;
            const size_t row = (size_t)b * T + c * 64 + 16 * it + (lane & 15);
#pragma unroll
            for (int vt = 0; vt < 4; ++vt) {
                o[vt] = (f32x4){__uint_as_float(oc[vt].x << 16), __uint_as_float(oc[vt].x & 0xffff0000u), __uint_as_float(oc[vt].y << 16), __uint_as_float(oc[vt].y & 0xffff0000u)};
                o[vt] = mma_lds<32>(Sb + vt * 16 * 40, 40, Qb + it * 16 * 40, 40, o[vt], lane);
                ss += (o[vt][0] * o[vt][0] + o[vt][1] * o[vt][1]) + (o[vt][2] * o[vt][2] + o[vt][3] * o[vt][3]); }
            ss += shx(ss, 16, lane); ss += shx(ss, 32, lane);
            const float rinv = rsqrtf(ss * (1.f / 64.f) + EPS);
#pragma unroll
            for (int vt = 0; vt < 4; ++vt) { const int v0 = 16 * vt + 4 * (lane >> 4);
                const v2u zw = zc[vt]; const f32x4 nw = vt == 0 ? nw0 : (vt == 1 ? nw1 : (vt == 2 ? nw2 : nw3));
                const float z0 = __uint_as_float(zw.x << 16), z1 = __uint_as_float(zw.x & 0xffff0000u), z2 = __uint_as_float(zw.y << 16), z3 = __uint_as_float(zw.y & 0xffff0000u);
                v2u w; w.x = pk2(o[vt][0] * rinv * nw[0] * siluf(z0), o[vt][1] * rinv * nw[1] * siluf(z1)); w.y = pk2(o[vt][2] * rinv * nw[2] * siluf(z2), o[vt][3] * rinv * nw[3] * siluf(z3));
                *(v2u*)(HEADS + row * D + 640 + h * 64 + v0) = w; }
        }
        S = dc * S + uc;
    }
    float* So = A.out + O_PGLA + (((size_t)l * 8 + b) * 6 + h) * 2048;
#pragma unroll
    for (int e = 0; e < 4; ++e) So[(k4 + e) * 64 + v] = S[e];
    __syncthreads();
}

__device__ __forceinline__ void m2_lru(CA& A, LAS unsigned char* lds, int l, int u, int tid, int lane, int wave) {
    const int b = u >> 2, blk = u & 3, ch = tid & 63, g = tid >> 6, cg = blk * 64 + ch;
    const bf16* PROJ = (const bf16*)(A.ws + WS_PROJ); bf16* HEADS = (bf16*)(A.ws + WS_XN);
    LAS bf16* Wr = (LAS bf16*)lds; LAS bf16* Wi = Wr + 64 * 72; LAS bf16* XCb = Wi + 64 * 72;
    LAS float* XC = (LAS float*)(lds + 27648); LAS float* AA = XC + 64 * 65; LAS float* BX = AA + 64 * 65; LAS float* SEGP = BX + 64 * 65; LAS float* SEGH = SEGP + 512;
#pragma unroll
    for (int j = 0; j < 8; ++j) { const int d = 8 * g + j; const size_t wi_ = (((size_t)l * 4 + blk) * 64 + d) * 64 + ch;
        Wr[ch * 72 + d] = (bf16)f2bf(A.in[15][wi_]); Wi[ch * 72 + d] = (bf16)f2bf(A.in[17][wi_]); }
    const float* cwp = A.in[13] + (size_t)l * 4 * 256;
    const float cw0 = cwp[cg], cw1 = cwp[256 + cg], cw2 = cwp[512 + cg], cw3 = cwp[768 + cg], cbb = A.in[14][l * 256 + cg];
    float gbr[2][4], gbi[2][4], gsp[2][4];
#pragma unroll
    for (int s = 0; s < 2; ++s) { const int e0 = 16 * ((wave >> 2) * 2 + s) + 4 * (lane >> 4);
#pragma unroll
        for (int e = 0; e < 4; ++e) { const int cc = l * 256 + blk * 64 + e0 + e; gbr[s][e] = A.in[16][cc]; gbi[s][e] = A.in[18][cc]; gsp[s][e] = -8.0f * log1pf(expf(-A.in[19][cc])); } }
    float hrun = 0.f;
    float xn[11], gn[8];
    { const long row0 = (long)b * T;
#pragma unroll
      for (int r = 0; r < 11; ++r) { const int i = 8 * g - 3 + r; xn[r] = i >= 0 ? bf2f(PROJ[(size_t)(row0 + i) * NPROJ + C_XB + cg]) : 0.f; }
#pragma unroll
      for (int j = 0; j < 8; ++j) gn[j] = bf2f(PROJ[(size_t)(row0 + 8 * g + j) * NPROJ + C_GB + cg]); }
    __syncthreads();
    for (int c = 0; c < 32; ++c) {
        const long row0 = (long)b * T + c * 64;
        float xc_[8], gbv[8];
#pragma unroll
        for (int j = 0; j < 8; ++j) { xc_[j] = xn[j] * cw0 + xn[j + 1] * cw1 + xn[j + 2] * cw2 + xn[j + 3] * cw3 + cbb; gbv[j] = gn[j]; }
        if (c + 1 < 32) {
#pragma unroll
            for (int r = 0; r < 11; ++r) xn[r] = bf2f(PROJ[(size_t)(row0 + 64 + 8 * g - 3 + r) * NPROJ + C_XB + cg]);
#pragma unroll
            for (int j = 0; j < 8; ++j) gn[j] = bf2f(PROJ[(size_t)(row0 + 64 + 8 * g + j) * NPROJ + C_GB + cg]); }
#pragma unroll
        for (int j = 0; j < 8; ++j) { XC[(8 * g + j) * 65 + ch] = xc_[j]; XCb[(8 * g + j) * 72 + ch] = (bf16)f2bf(xc_[j]); }
        __syncthreads();
        { const int it = wave & 3, i = 16 * it + (lane & 15);
#pragma unroll
          for (int s = 0; s < 2; ++s) { const int et = (wave >> 2) * 2 + s, e0 = 16 * et + 4 * (lane >> 4);
            f32x4 ar = (f32x4){0.f, 0.f, 0.f, 0.f}, ai = ar;
            ar = mma_lds<64>(Wr + et * 16 * 72, 72, XCb + it * 16 * 72, 72, ar, lane);
            ai = mma_lds<64>(Wi + et * 16 * 72, 72, XCb + it * 16 * 72, 72, ai, lane);
#pragma unroll
            for (int e = 0; e < 4; ++e) { const float r = sigm(ar[e] + gbr[s][e]), ig = sigm(ai[e] + gbi[s][e]); const float la = r * gsp[s][e];
                const float a = __expf(la); AA[i * 65 + e0 + e] = a; BX[i * 65 + e0 + e] = __builtin_amdgcn_sqrtf((1.0f - a) * (1.0f + a)) * ig * XC[i * 65 + e0 + e]; } } }
        __syncthreads();
        float av[8], bv[8]; float hl = 0.f, pl = 1.f;
#pragma unroll
        for (int j = 0; j < 8; ++j) { av[j] = AA[(8 * g + j) * 65 + ch]; bv[j] = BX[(8 * g + j) * 65 + ch]; hl = av[j] * hl + bv[j]; pl *= av[j]; }
        SEGP[g * 64 + ch] = pl; SEGH[g * 64 + ch] = hl;
        __syncthreads();
        float hin = hrun, hall = hrun;
#pragma unroll
        for (int q = 0; q < 8; ++q) { const float p = SEGP[q * 64 + ch], hh = SEGH[q * 64 + ch]; hall = p * hall + hh; if (q < g) hin = hall; }
        hrun = hall;
#pragma unroll
        for (int j = 0; j < 8; ++j) { hin = av[j] * hin + bv[j]; HEADS[(size_t)(row0 + 8 * g + j) * D + 384 + cg] = (bf16)f2bf(hin * gelu_t(gbv[j])); }
    }
    if (wave == 0) { A.out[O_PLRU + ((size_t)l * 8 + b) * 256 + cg] = hrun;
#pragma unroll
        for (int r = 0; r < 3; ++r) A.out[O_PLCONV + (((size_t)l * 8 + b) * 3 + r) * 256 + cg] = bf2f(PROJ[((size_t)b * T + 2045 + r) * NPROJ + C_XB + cg]); }
    __syncthreads();
}

__device__ __forceinline__ void lru_sample_wg(CA& A, LAS unsigned char* lds, int l, int u, int tid, int lane, int wave) {
    const int grp = u >> 2, blk = u & 3, ch = tid & 63, g = tid >> 6, cg = blk * 64 + ch, bs = grp * 8 + g;
    const bf16* PROJ = (const bf16*)(A.ws + WS_PROJ); bf16* HEADS = (bf16*)(A.ws + WS_XN);
    LAS bf16* Wr = (LAS bf16*)lds; LAS bf16* Wi = Wr + 64 * 72; LAS bf16* XCb = Wi + 64 * 72;
    LAS float* XC = (LAS float*)(lds + 27648); LAS float* AA = XC + 64 * 65; LAS float* BX = AA + 64 * 65; LAS float* HO = BX + 64 * 65;
#pragma unroll
    for (int j = 0; j < 8; ++j) { const int d = 8 * g + j; const size_t wi_ = (((size_t)l * 4 + blk) * 64 + d) * 64 + ch;
        Wr[ch * 72 + d] = (bf16)f2bf(A.in[15][wi_]); Wi[ch * 72 + d] = (bf16)f2bf(A.in[17][wi_]); }
    const float* cwp = A.in[13] + (size_t)l * 4 * 256;
    const float cw0 = cwp[cg], cw1 = cwp[256 + cg], cw2 = cwp[512 + cg], cw3 = cwp[768 + cg], cbb = A.in[14][l * 256 + cg];
    const size_t row0 = (size_t)MP + grp * 64;
    float xn[11], gbv[8];
    const float* cs = A.in[4] + ((size_t)l * 128 + bs) * 3 * 256;
    xn[0] = cs[cg]; xn[1] = cs[256 + cg]; xn[2] = cs[512 + cg];
#pragma unroll
    for (int j = 0; j < 8; ++j) { xn[3 + j] = bf2f(PROJ[(row0 + 8 * g + j) * NPROJ + C_XB + cg]); gbv[j] = bf2f(PROJ[(row0 + 8 * g + j) * NPROJ + C_GB + cg]); }
#pragma unroll
    for (int j = 0; j < 8; ++j) { const float xc = xn[j] * cw0 + xn[j + 1] * cw1 + xn[j + 2] * cw2 + xn[j + 3] * cw3 + cbb; XC[(8 * g + j) * 65 + ch] = xc; XCb[(8 * g + j) * 72 + ch] = (bf16)f2bf(xc); }
#pragma unroll
    for (int r = 0; r < 3; ++r) A.out[O_SLCONV + (((size_t)l * 128 + bs) * 3 + r) * 256 + cg] = xn[8 + r];
    __syncthreads();
    { const int it = wave & 3, i = 16 * it + (lane & 15);
#pragma unroll
      for (int s = 0; s < 2; ++s) { const int et = (wave >> 2) * 2 + s, e0 = 16 * et + 4 * (lane >> 4);
        f32x4 ar = (f32x4){0.f, 0.f, 0.f, 0.f}, ai = ar;
        ar = mma_lds<64>(Wr + et * 16 * 72, 72, XCb + it * 16 * 72, 72, ar, lane);
        ai = mma_lds<64>(Wi + et * 16 * 72, 72, XCb + it * 16 * 72, 72, ai, lane);
        const f32x4 br = *(const f32x4*)(A.in[16] + l * 256 + blk * 64 + e0), bi = *(const f32x4*)(A.in[18] + l * 256 + blk * 64 + e0), lam = *(const f32x4*)(A.in[19] + l * 256 + blk * 64 + e0);
#pragma unroll
        for (int e = 0; e < 4; ++e) { const float r = sigm(ar[e] + br[e]), ig = sigm(ai[e] + bi[e]); const float la = -8.0f * r * log1pf(expf(-lam[e]));
            AA[i * 65 + e0 + e] = expf(la); BX[i * 65 + e0 + e] = sqrtf(-expm1f(2.0f * la)) * ig * XC[i * 65 + e0 + e]; } } }
    __syncthreads();
    { float h = A.in[5][((size_t)l * 128 + bs) * 256 + cg];
#pragma unroll
      for (int j = 0; j < 8; ++j) { const int i = 8 * g + j; h = AA[i * 65 + ch] * h + BX[i * 65 + ch]; HEADS[(row0 + i) * D + 384 + cg] = (bf16)f2bf(h * gelu_t(gbv[j])); }
      A.out[O_SLRU + ((size_t)l * 128 + bs) * 256 + cg] = h; }
    __syncthreads();
}

#define XB_TMO      128
#define XB_XCNT(j)  (256  + 64 * (j))
#define XB_XSUB(j)  (1280 + 64 * (j))
#define XB_XGEN(j)  (2304 + 64 * (j))
#define XB_TOP      3328
#define XB_TOPGEN   3392
#define XCD_BAR_WORDS 3456
#define XB_SPIN_CAP (1u << 18)

__device__ __forceinline__ unsigned xb_ld(unsigned* p)              { return __hip_atomic_load(p, __ATOMIC_RELAXED, __HIP_MEMORY_SCOPE_AGENT); }
__device__ __forceinline__ unsigned xb_add(unsigned* p, unsigned v) { return __hip_atomic_fetch_add(p, v, __ATOMIC_RELAXED, __HIP_MEMORY_SCOPE_AGENT); }
__device__ __forceinline__ unsigned xb_xcc_id() { return (unsigned)__builtin_amdgcn_s_getreg((3 << 11) | 20) & 0xFu; }
#define XB_SPIN(cond, bar) do { unsigned _sp = 0; while (cond) { __builtin_amdgcn_s_sleep(1); \
    if ((++_sp & 255u) == 0u) { if (xb_ld(&(bar)[XB_TMO])) break; if (_sp > XB_SPIN_CAP) { atomicAdd(&(bar)[XB_TMO], 1u); break; } } } } while (0)

struct XcdBarrier {
    unsigned* bar; unsigned x;
    volatile LAS unsigned* st;
};

__device__ __forceinline__ XcdBarrier xcd_barrier_post(unsigned* bar, volatile LAS unsigned* st, const bool leader) {
    XcdBarrier b; b.bar = bar; b.x = xb_xcc_id(); b.st = st;
    if (leader) (void)xb_add(&bar[XB_XCNT(b.x)], 1u);
    return b;
}
__device__ __forceinline__ void xcd_barrier_complete(unsigned* bar, unsigned x, unsigned& nloc, unsigned& nx) {
    const unsigned G = gridDim.x * gridDim.y * gridDim.z;
    unsigned sum, cnt, mine, sp = 0u;
    for (;;) {
        sum = 0u; cnt = 0u; mine = 0u;
#pragma unroll
        for (unsigned j = 0; j < 16; ++j) { const unsigned c = xb_ld(&bar[XB_XCNT(j)]); sum += c; cnt += (c > 0u) ? 1u : 0u; mine = (j == x) ? c : mine; }
        if (sum == G) break;
        __builtin_amdgcn_s_sleep(1);
        if ((++sp & 255u) == 0u) { if (xb_ld(&bar[XB_TMO])) break; if (sp > XB_SPIN_CAP) { atomicAdd(&bar[XB_TMO], 1u); break; } }
    }
    nloc = mine > 0u ? mine : 1u; nx = cnt > 0u ? cnt : 1u;
}

__device__ __forceinline__ void xcd_barrier(const XcdBarrier& b, const bool leader) {
    asm volatile("s_waitcnt vmcnt(0)" ::: "memory");
    __syncthreads();
    if (leader) {
        unsigned* bar = b.bar;
        __builtin_amdgcn_s_waitcnt(0);
        unsigned nloc = b.st[0], nx = b.st[1];
        if (nloc == 0u) { xcd_barrier_complete(bar, b.x, nloc, nx); b.st[0] = nloc; b.st[1] = nx; }
        const unsigned old = xb_add(&bar[XB_XSUB(b.x)], 1u);
        const unsigned gen = old / nloc;
        if (old + 1u == (gen + 1u) * nloc) {
            __builtin_amdgcn_fence(__ATOMIC_RELEASE, "agent");
            asm volatile("s_waitcnt vmcnt(0)" ::: "memory");
            const unsigned og = xb_add(&bar[XB_TOP], 1u);
            const unsigned tg = og / nx;
            if (og + 1u == (tg + 1u) * nx) xb_add(&bar[XB_TOPGEN], 1u);
            else XB_SPIN(xb_ld(&bar[XB_TOPGEN]) == tg, bar);
            __builtin_amdgcn_fence(__ATOMIC_ACQUIRE, "agent");
            xb_add(&bar[XB_XGEN(b.x)], 1u);
            asm volatile("s_waitcnt vmcnt(0)" ::: "memory");
        } else {
            XB_SPIN(xb_ld(&bar[XB_XGEN(b.x)]) == gen, bar);
            __builtin_amdgcn_fence(__ATOMIC_ACQUIRE, "agent");
            asm volatile("s_waitcnt vmcnt(0)" ::: "memory");
        }
    }
    __syncthreads();
}

#define FRESHA() CA* Aq = Ap; asm volatile("" : "+s"(Aq)); CA& A = *Aq;
#define FRESH() int tid = wave * 64 + fresh_lane(); asm volatile("" : "+v"(tid)); const int lane = tid & 63; (void)lane; LAS unsigned char* lds = lds0; asm volatile("" : "+v"(lds)); (void)lds; FRESHA();
#ifndef PH
#define PH 0xffff
#endif
#ifndef REP_M1
#define REP_M1 1
#endif
#ifndef REP_M2
#define REP_M2 1
#endif
#ifndef REP_G1
#define REP_G1 1
#endif
#ifndef REP_G3
#define REP_G3 1
#endif
#define GSYNC() do { XcdBarrier xb_; xb_.bar = (unsigned*)Ap->ws + 4096; xb_.x = xb_xcc_id(); const unsigned ln_ = (unsigned)fresh_lane(); LAS unsigned char* lb_ = lds0; asm volatile("" : "+v"(lb_)); xb_.st = (volatile LAS unsigned*)(lb_ + 147392); xcd_barrier(xb_, wave == 0 && ln_ == 0u); } while (0)
template <int l> __device__ __forceinline__ void layer_body(CA* Ap, LAS unsigned char* lds0, const int wave, const int bid, const int G, const int gw, const int NGW) {
        for (int rep = 0; rep < REP_G1; ++rep) if (PH & 1) { FRESHA(); pg8::Gemm g{(const bf16*)(A.ws + WS_XN), (const bf16*)(A.ws + WS_WIN), M, NPROJ, D}; pg8::StaticOrder S; S.init(M, NPROJ, G, bid);
          pg8::EpiProj E{(bf16*)(A.ws + WS_PROJ), NPROJ};
          pg8::gemm_phase<pg8::EpiProj, pg8::StaticOrder, true, true>(lds0, g, S, E, wave); }
        GSYNC();
        for (int rep = 0; rep < REP_M1; ++rep) {
            for (int u = bid; u < 768 + 768; u += G) { FRESH(); if (u < 768) { if (PH & 8) m1_delta_pair(A, lds, l, u, tid, lane, wave); } else { if (PH & 16) m1_gla_pair(A, lds, l, u - 768, tid, lane, wave); } }
        }
        GSYNC();
        {
            for (int rep = 0; rep < REP_M2; ++rep) for (int u = bid; u < 128; u += G) { FRESH(); if (u < 48) { if (PH & 32) m2_delta(A, lds, l, u, tid, lane, wave); } else if (u < 96) { if ((PH & 64) && rep == 0) m2_gla(A, lds, l, u - 48, tid, lane, wave); } else { if (PH & 128) m2_lru(A, lds, l, u - 96, tid, lane, wave); } __syncthreads(); }
            if (PH & 2) for (int u = bid - 128; u >= 0 && u < 64; u += (G > 128 ? G - 128 : G)) { FRESH(); lru_sample_wg(A, lds, l, u, tid, lane, wave); }
            int li, ln; if (G > 128) { li = (bid - 128) * NWAVES + wave; ln = (G - 128) * NWAVES; } else { li = gw; ln = NGW; }
            if (li >= 0) {
                if (PH & 4) for (int it = li; it < 1536; it += ln) { FRESH(); if (it < 768) sample_delta_item(A, l, it, lane); else sample_gla_item(A, l, it - 768, lane); }
            }
            if (G == 256 ? (bid < 96 || bid >= 128) : true) { FRESH();
                const int ci = G == 256 ? ((bid < 96 ? bid : bid - 32) * NWAVES + wave) : gw, cn = G == 256 ? 224 * NWAVES : NGW;
                convert_weights(A, lds, l, CONV_IN, CONV_ALL, ci, cn, wave, lane);
                if (l == 0) convert_weights(A, lds, 1, 0, CONV_IN, ci, cn, wave, lane); }
        }
        GSYNC();
        if (PH & 256) { FRESHA(); float* XF = A.out; pg8::Gemm g{(const bf16*)(A.ws + WS_XN), (const bf16*)(A.ws + WS_WOUT), M, D, D}; pg8::TailOrder S; S.init(G, bid, D);
          pg8::EpiResidT<false, true> E{l == 0 ? A.in[0] : XF, XF, ALPHA, (float*)(A.ws + WS_PART), 4, nullptr, (pg8::bf16_t*)(A.ws + WS_YB1)};
          pg8::gemm_phase<pg8::EpiResidT<false, true>, pg8::TailOrder, true, true>(lds0, g, S, E, wave); }
        GSYNC();
        { FRESH(); ln_pass<4, true, true>(A, A.in[24] + l * D, A.in[25] + l * D, true, false, (const float*)(A.ws + WS_PART), (const bf16*)(A.ws + WS_YB1), gw, NGW, lane); }
        GSYNC();
        for (int rep = 0; rep < REP_G3; ++rep) if (PH & 512) { FRESHA(); bf16* HB = (bf16*)(A.ws + WS_H); pg8::Gemm g{(const bf16*)(A.ws + WS_XN), (const bf16*)(A.ws + WS_WUP), M, NUP, D}; pg8::StaticOrder S; S.init(M, NUP, G, bid);
          pg8::EpiFfn E{HB, (float*)(A.ws + WS_GH), (float*)(A.ws + WS_GF), A.in[27] + (size_t)l * 3 * DFF, A.in[28] + (size_t)l * DFF, A.in[7] + (size_t)l * 128 * 2 * DFF,
                        A.out + O_PFCONV + (size_t)l * 8 * 2 * DFF, A.out + O_SFCONV + (size_t)l * 128 * 2 * DFF};
          pg8::gemm_phase<pg8::EpiFfn, pg8::StaticOrder, true, true>(lds0, g, S, E, wave); }
        GSYNC();
        if (PH & 1024) { FRESH(); float* XF = A.out; bf16* HB = (bf16*)(A.ws + WS_H); pg8::Gemm g{HB, (const bf16*)(A.ws + WS_WDN), M, D, DFF}; pg8::TailOrder S; S.init(G, bid, DFF);
          { const float* GH = (const float*)(A.ws + WS_GH); const float* GF = (const float*)(A.ws + WS_GF);
            const float* cw = A.in[27] + (size_t)l * 3 * DFF; const float* cb = A.in[28] + (size_t)l * DFF;
            pg8::Unit u;
            for (int i = 0; S.next(i, u); ++i) { if (u.pm >= 64) continue;
                f32x4 w0[2], w1[2], w2[2], bb[2];
#pragma unroll
                for (int q = 0; q < 2; ++q) { const int c = 4 * (tid + 512 * q); if (c < DFF) { w0[q] = *(const f32x4*)(cw + c); w1[q] = *(const f32x4*)(cw + DFF + c); w2[q] = *(const f32x4*)(cw + 2 * DFF + c); bb[q] = *(const f32x4*)(cb + c); } }
#pragma unroll
                for (int sl = 0; sl < 4; ++sl) { const int sp = 4 * u.pm + sl; const bool first = (sp & 31) == 0;
                    f32x4 a00[2], a01[2], a10[2], a11[2], h0[2], h1[2];
#pragma unroll
                    for (int q = 0; q < 2; ++q) { const int c = 4 * (tid + 512 * q); if (c < DFF) {
                        a00[q] = *(const f32x4*)(GF + (((size_t)sp * 2 + 0) * 2 + 0) * DFF + c); a01[q] = *(const f32x4*)(GF + (((size_t)sp * 2 + 0) * 2 + 1) * DFF + c);
                        a10[q] = *(const f32x4*)(GF + (((size_t)sp * 2 + 1) * 2 + 0) * DFF + c); a11[q] = *(const f32x4*)(GF + (((size_t)sp * 2 + 1) * 2 + 1) * DFF + c);
                        if (!first) { h0[q] = *(const f32x4*)(GH + ((size_t)(sp - 1) * 2 + 0) * DFF + c); h1[q] = *(const f32x4*)(GH + ((size_t)(sp - 1) * 2 + 1) * DFF + c); }
                        else { h0[q] = (f32x4){0.f, 0.f, 0.f, 0.f}; h1[q] = h0[q]; } } }
#pragma unroll
                    for (int q = 0; q < 2; ++q) { const int c = 4 * (tid + 512 * q); if (c < DFF) {
                        const f32x4 x0 = h0[q] * w0[q] + h1[q] * w1[q] + a00[q] * w2[q] + bb[q], x1 = h1[q] * w0[q] + a00[q] * w1[q] + a10[q] * w2[q] + bb[q];
                        v2u o0, o1;
                        o0.x = pk2(pg8::gelu_tanh_f(x0[0]) * a01[q][0], pg8::gelu_tanh_f(x0[1]) * a01[q][1]); o0.y = pk2(pg8::gelu_tanh_f(x0[2]) * a01[q][2], pg8::gelu_tanh_f(x0[3]) * a01[q][3]);
                        o1.x = pk2(pg8::gelu_tanh_f(x1[0]) * a11[q][0], pg8::gelu_tanh_f(x1[1]) * a11[q][1]); o1.y = pk2(pg8::gelu_tanh_f(x1[2]) * a11[q][2], pg8::gelu_tanh_f(x1[3]) * a11[q][3]);
                        *(v2u*)(HB + (size_t)(64 * sp) * DFF + c) = o0; *(v2u*)(HB + (size_t)(64 * sp + 1) * DFF + c) = o1; } } } }
            __threadfence(); __syncthreads(); }
          pg8::EpiResidT<true, l == 0> E{XF, XF, ALPHA, (float*)(A.ws + WS_PART), 11, (const pg8::bf16_t*)(A.ws + WS_XN), (pg8::bf16_t*)(A.ws + WS_YB2)};
          pg8::gemm_phase<pg8::EpiResidT<true, l == 0>, pg8::TailOrder, true, true>(lds0, g, S, E, wave); }
        GSYNC();
        { FRESH(); ln_pass<11, l == 0, l == 0>(A, A.in[30] + l * D, A.in[31] + l * D, l == 0, true, (const float*)(A.ws + WS_PART), (const bf16*)(A.ws + WS_YB2), gw, NGW, lane); }
        if (l == 0) GSYNC();
}

__global__ void __launch_bounds__(NTHR, 2) hybrid_fwd(Args Akern) {
    extern __shared__ __attribute__((aligned(16))) unsigned char lds_raw[];
    cg::grid_group grid = cg::this_grid();
    LAS unsigned char* lds0 = (LAS unsigned char*)lds_raw;
    const int tid0 = threadIdx.x, wave = __builtin_amdgcn_readfirstlane(tid0 >> 6), bid = blockIdx.x, G = gridDim.x;
    const int gw = bid * NWAVES + wave, NGW = G * NWAVES;
    CA* Ap = (CA*)__builtin_amdgcn_kernarg_segment_ptr();

    unsigned* barw = (unsigned*)Akern.ws + 4096;
    volatile LAS unsigned* bst = (volatile LAS unsigned*)(lds0 + 147392);
    if (tid0 < 2) bst[tid0] = 0u;
    (void)xcd_barrier_post(barw, bst, tid0 == 0);
    if (Akern.ws == nullptr) grid.sync();
    { FRESH(); convert_weights(A, lds, 0, 0, CONV_IN, gw, NGW, wave, lane); }
    { FRESH(); x_to_bf16(A, gw, NGW, lane); }
    GSYNC();

    layer_body<0>(Ap, lds0, wave, bid, G, gw, NGW);
    layer_body<1>(Ap, lds0, wave, bid, G, gw, NGW);
}

extern "C" void kernel_launch(void* const* d_in, const int* in_sizes, int n_in, void* d_out, int out_size, void* d_ws, size_t ws_size, hipStream_t stream) {
    static int grid = 0;
    if (grid == 0) {
        int dev = 0, cus = 0, per_cu = 0;
        if (n_in != 32 || (size_t)out_size != O_END || ws_size < 256 * MiB) { fprintf(stderr, "kernel_launch: unexpected shapes n_in %d out %d ws %zu\n", n_in, out_size, ws_size); grid = -1; return; }
        (void)hipGetDevice(&dev); (void)hipDeviceGetAttribute(&cus, hipDeviceAttributeMultiprocessorCount, dev);
        (void)hipFuncSetAttribute((const void*)hybrid_fwd, hipFuncAttributeMaxDynamicSharedMemorySize, LDS_BYTES);
        (void)hipOccupancyMaxActiveBlocksPerMultiprocessor(&per_cu, (const void*)hybrid_fwd, NTHR, LDS_BYTES);
        (void)hipGetLastError();
        if (per_cu < 1) per_cu = 1;
        grid = cus;
    }
    if (grid < 0) return;
    if (hipMemsetAsync(d_ws, 0, 65536, stream) != hipSuccess) { fprintf(stderr, "kernel_launch: hipMemsetAsync of the control words failed\n"); return; }
    Args a{};
    for (int i = 0; i < 32; ++i) a.in[i] = (const float*)d_in[i];
    a.out = (float*)d_out; a.ws = (unsigned char*)d_ws;
    void* args[] = {&a};
    hipError_t e = hipLaunchCooperativeKernel((const void*)hybrid_fwd, dim3(grid), dim3(NTHR), args, LDS_BYTES, stream);
    if (e != hipSuccess) fprintf(stderr, "cooperative launch failed: %s (grid %d)\n", hipGetErrorString(e), grid);
}
```
